# Optimizing an MI355X kernel written in HIP

```python
import jax
import jax.numpy as jnp
from jax import lax
import numpy as np

D_MODEL = 2048
BATCH = 8
SEQ = 4096
DEPTH = 2

CONV_CH = 512
CONV_WIDTH = 31
GMLP_HEADS = 4
GMLP_HEAD_CH = 128
GMLP_CH = GMLP_HEADS * GMLP_HEAD_CH
CHUNK = 128
ATT_HEADS = 8
HEAD_DIM = 128
ATT_CH = ATT_HEADS * HEAD_DIM
Q_BLOCK = 128
MIX_WIDTH = CONV_CH + GMLP_CH + ATT_CH

OFF_CONV = 0
OFF_GMLP = OFF_CONV + 2 * CONV_CH
OFF_Q = OFF_GMLP + 2 * GMLP_CH
OFF_K = OFF_Q + ATT_CH
OFF_V = OFF_K + ATT_CH
OFF_F = OFF_V + ATT_CH
N_IN = OFF_F + ATT_HEADS

N_EXPERTS = 64
TOP_K = 8
N_GROUPS = 8
TOPK_GROUPS = 4
D_EXPERT = 512
D_SHARED = 512
ROUTE_SCALE = 2.5
MOE_BLOCK = 128

D_PLE = 256
ALPHA = (2.0 * DEPTH) ** 0.25
BETA = (8.0 * DEPTH) ** -0.25
LN_EPS = 1e-5

kernel_name = "hybrid_conv_gmlp_fox_moe_deepnorm"


def layer_norm(x, g, b):
    xf = x.astype(jnp.float32)
    mu = jnp.mean(xf, axis=-1, keepdims=True)
    var = jnp.mean(jnp.square(xf - mu), axis=-1, keepdims=True)
    return ((xf - mu) * lax.rsqrt(var + LN_EPS) * g.astype(jnp.float32) + b.astype(jnp.float32)).astype(x.dtype)


def rms_normalise(x):
    xf = x.astype(jnp.float32)
    return (xf * lax.rsqrt(jnp.mean(jnp.square(xf), axis=-1, keepdims=True) + LN_EPS)).astype(x.dtype)


def conv_module(z, conv_w, conv_b, ln_g, ln_b):
    a, gate = jnp.split(z, 2, axis=-1)
    h = a * jax.nn.sigmoid(gate)
    h = lax.conv_general_dilated(
        h, conv_w[:, None, :], window_strides=(1,),
        padding=[(CONV_WIDTH - 1, 0)],
        dimension_numbers=("NWC", "WIO", "NWC"),
        feature_group_count=CONV_CH) + conv_b
    h = layer_norm(h, ln_g, ln_b)
    return jax.nn.silu(h)


def gmlp_module(z, ln_g, ln_b, w_sp, b_sp):
    bsz, seq, _ = z.shape
    z = jax.nn.gelu(z)
    u, v = jnp.split(z, 2, axis=-1)
    v = layer_norm(v, ln_g, ln_b)
    v = v.reshape(bsz, seq // CHUNK, CHUNK, GMLP_HEADS, GMLP_HEAD_CH)
    causal = jnp.tril(jnp.ones((CHUNK, CHUNK), dtype=bool))
    ws = jnp.where(causal, w_sp, 0)
    mixed = jnp.einsum("hts,bnshc->bnthc", ws, v) + b_sp.T[None, None, :, :, None]
    return u * mixed.reshape(bsz, seq, GMLP_CH)


def fox_attention(q, k, v, f_logit):
    bsz, seq, nh, dh = q.shape
    c = jnp.cumsum(jax.nn.log_sigmoid(f_logit.astype(jnp.float32)), axis=1)
    c_t = c.transpose(0, 2, 1)
    nq = seq // Q_BLOCK
    qb = q.reshape(bsz, nq, Q_BLOCK, nh, dh).transpose(1, 0, 2, 3, 4)
    cb = c_t.reshape(bsz, nh, nq, Q_BLOCK).transpose(2, 0, 1, 3)
    kpos = jnp.arange(seq)
    scale = dh ** -0.5

    def block(args):
        i, qi, ci = args
        s = jnp.einsum("bqhd,bkhd->bhqk", qi, k, preferred_element_type=jnp.float32) * scale
        s = s + (ci[..., :, None] - c_t[..., None, :])
        qpos = i * Q_BLOCK + jnp.arange(Q_BLOCK)
        s = jnp.where(kpos[None, :] <= qpos[:, None], s, -jnp.inf)
        pr = jax.nn.softmax(s, axis=-1)
        return jnp.einsum("bhqk,bkhd->bqhd", pr.astype(v.dtype), v)

    out = lax.map(block, (jnp.arange(nq), qb, cb))
    return out.transpose(1, 0, 2, 3, 4).reshape(bsz, seq, nh * dh)


def mixing_sublayer(x, w_in, b_f, conv_w, conv_b, conv_ln_g, conv_ln_b,
                    gmlp_ln_g, gmlp_ln_b, w_sp, b_sp, out_g, w_o):
    bsz, seq, _ = x.shape
    z = x @ w_in
    y_a = conv_module(z[..., OFF_CONV:OFF_GMLP], conv_w, conv_b, conv_ln_g, conv_ln_b)
    y_b = gmlp_module(z[..., OFF_GMLP:OFF_Q], gmlp_ln_g, gmlp_ln_b, w_sp, b_sp)
    q = z[..., OFF_Q:OFF_K].reshape(bsz, seq, ATT_HEADS, HEAD_DIM)
    k = z[..., OFF_K:OFF_V].reshape(bsz, seq, ATT_HEADS, HEAD_DIM)
    v = z[..., OFF_V:OFF_F].reshape(bsz, seq, ATT_HEADS, HEAD_DIM)
    y_c = fox_attention(q, k, v, z[..., OFF_F:N_IN] + b_f)
    y = jnp.concatenate([rms_normalise(y_a), rms_normalise(y_b), rms_normalise(y_c)], axis=-1) * out_g
    return y @ w_o


def route(x2, w_r, r_bias):
    n_tok = x2.shape[0]
    scores = jax.nn.sigmoid((x2 @ w_r).astype(jnp.float32))
    sel = scores + r_bias.astype(jnp.float32)
    grp_score = lax.top_k(sel.reshape(n_tok, N_GROUPS, N_EXPERTS // N_GROUPS), 2)[0].sum(-1)
    _, gidx = lax.top_k(grp_score, TOPK_GROUPS)
    gmask = jnp.any(gidx[..., None] == jnp.arange(N_GROUPS), axis=1)
    emask = jnp.repeat(gmask, N_EXPERTS // N_GROUPS, axis=1)
    _, eidx = lax.top_k(jnp.where(emask, sel, -jnp.inf), TOP_K)
    gates = jnp.take_along_axis(scores, eidx, axis=1)
    gates = gates / jnp.sum(gates, axis=-1, keepdims=True) * ROUTE_SCALE
    return eidx, gates


def routed_experts(x2, eidx, gates, w_e1, w_e3, w_e2):
    n_tok, d = x2.shape
    n_asg = n_tok * TOP_K
    flat_e = eidx.reshape(n_asg)
    flat_tok = jnp.repeat(jnp.arange(n_tok, dtype=jnp.int32), TOP_K)
    flat_g = gates.reshape(n_asg)
    order = jnp.argsort(flat_e)
    se, stok, sg = flat_e[order], flat_tok[order], flat_g[order]
    counts = jnp.bincount(flat_e, length=N_EXPERTS)
    start = jnp.cumsum(counts) - counts
    padded = (counts + MOE_BLOCK - 1) // MOE_BLOCK * MOE_BLOCK
    pend = jnp.cumsum(padded)
    pstart = pend - padded
    dest = pstart[se] + jnp.arange(n_asg) - start[se]
    n_blk = -(-n_asg // MOE_BLOCK) + N_EXPERTS
    n_rows = n_blk * MOE_BLOCK
    row_tok = jnp.zeros((n_rows,), jnp.int32).at[dest].set(stok)
    row_gate = jnp.zeros((n_rows,), x2.dtype).at[dest].set(sg.astype(x2.dtype))
    blk_exp = jnp.minimum(jnp.searchsorted(pend, jnp.arange(n_blk) * MOE_BLOCK, side="right"), N_EXPERTS - 1)

    def step(acc, args):
        toks, g, e = args
        xb = x2[toks]
        h = jax.nn.silu(xb @ w_e1[e]) * (xb @ w_e3[e])
        return acc.at[toks].add((h @ w_e2[e]) * g[:, None]), None

    out, _ = lax.scan(step, jnp.zeros_like(x2),
                      (row_tok.reshape(n_blk, MOE_BLOCK), row_gate.reshape(n_blk, MOE_BLOCK), blk_exp))
    return out


def setup_inputs(seed: int = 0) -> dict:
    key = jax.random.key(seed)
    ks = jax.random.split(key, 32)

    def nrm(k, shape, scale):
        return jax.random.normal(k, shape, jnp.float32) * scale

    L, D = DEPTH, D_MODEL
    return {
        "x": nrm(ks[0], (BATCH, SEQ, D), 1.0),
        "p": nrm(ks[1], (DEPTH, BATCH, SEQ, D_PLE), 1.0),
        "w_in": nrm(ks[2], (L, D, N_IN), D ** -0.5),
        "b_f": 2.0 + nrm(ks[3], (L, ATT_HEADS), 0.5),
        "conv_w": nrm(ks[4], (L, CONV_WIDTH, CONV_CH), CONV_WIDTH ** -0.5),
        "conv_b": nrm(ks[5], (L, CONV_CH), 0.02),
        "conv_ln_g": 1.0 + nrm(ks[6], (L, CONV_CH), 0.02),
        "conv_ln_b": nrm(ks[7], (L, CONV_CH), 0.02),
        "gmlp_ln_g": 1.0 + nrm(ks[8], (L, GMLP_CH), 0.02),
        "gmlp_ln_b": nrm(ks[9], (L, GMLP_CH), 0.02),
        "w_sp": nrm(ks[10], (L, GMLP_HEADS, CHUNK, CHUNK), CHUNK ** -0.5),
        "b_sp": 1.0 + nrm(ks[11], (L, GMLP_HEADS, CHUNK), 0.1),
        "out_g": 1.0 + nrm(ks[12], (L, MIX_WIDTH), 0.02),
        "w_o": nrm(ks[13], (L, MIX_WIDTH, D), BETA * MIX_WIDTH ** -0.5),
        "ln1_g": 1.0 + nrm(ks[14], (L, D), 0.02),
        "ln1_b": nrm(ks[15], (L, D), 0.02),
        "w_r": nrm(ks[16], (L, D, N_EXPERTS), D ** -0.5),
        "r_bias": nrm(ks[17], (L, N_EXPERTS), 0.01),
        "w_e1": nrm(ks[18], (L, N_EXPERTS, D, D_EXPERT), D ** -0.5),
        "w_e3": nrm(ks[19], (L, N_EXPERTS, D, D_EXPERT), D ** -0.5),
        "w_e2": nrm(ks[20], (L, N_EXPERTS, D_EXPERT, D), BETA * D_EXPERT ** -0.5),
        "w_sh1": nrm(ks[21], (L, D, D_SHARED), D ** -0.5),
        "w_sh3": nrm(ks[22], (L, D, D_SHARED), D ** -0.5),
        "w_sh2": nrm(ks[23], (L, D_SHARED, D), BETA * D_SHARED ** -0.5),
        "w_pe": nrm(ks[24], (L, D_PLE, D), BETA * D_PLE ** -0.5),
        "w_pg": nrm(ks[25], (L, D, D), D ** -0.5),
        "b_pg": nrm(ks[26], (L, D), 0.02),
        "ln2_g": 1.0 + nrm(ks[27], (L, D), 0.02),
        "ln2_b": nrm(ks[28], (L, D), 0.02),
    }


def reference(x, p, w_in, b_f, conv_w, conv_b, conv_ln_g, conv_ln_b, gmlp_ln_g, gmlp_ln_b,
              w_sp, b_sp, out_g, w_o, ln1_g, ln1_b, w_r, r_bias, w_e1, w_e3, w_e2,
              w_sh1, w_sh3, w_sh2, w_pe, w_pg, b_pg, ln2_g, ln2_b):
    bsz, seq, d = x.shape
    for i in range(DEPTH):
        h = mixing_sublayer(x, w_in[i], b_f[i], conv_w[i], conv_b[i], conv_ln_g[i], conv_ln_b[i],
                            gmlp_ln_g[i], gmlp_ln_b[i], w_sp[i], b_sp[i], out_g[i], w_o[i])
        x = layer_norm(ALPHA * x + h, ln1_g[i], ln1_b[i])
        x2 = x.reshape(bsz * seq, d)
        eidx, gates = route(x2, w_r[i], r_bias[i])
        moe = routed_experts(x2, eidx, gates, w_e1[i], w_e3[i], w_e2[i])
        moe = moe + (jax.nn.silu(x2 @ w_sh1[i]) * (x2 @ w_sh3[i])) @ w_sh2[i]
        ple = jax.nn.sigmoid(x @ w_pg[i] + b_pg[i]) * (p[i] @ w_pe[i])
        x = layer_norm(ALPHA * x + moe.reshape(bsz, seq, d) + ple, ln2_g[i], ln2_b[i])
    return x
```

```cpp
#include <hip/hip_runtime.h>
#include <cstdio>
#include <cstdint>

#define LAS __attribute__((address_space(3)))
typedef unsigned short bf16_t;
typedef float f32x4 __attribute__((ext_vector_type(4)));
typedef float f32x2 __attribute__((ext_vector_type(2)));

namespace {
constexpr int NB = 8, S = 4096, T = NB * S, D = 2048, DEPTH = 2;
constexpr int CONV_CH = 512, CONV_W = 31, GM_CH = 512, CHUNK = 128, AH = 8, HD = 128;
constexpr int OFF_GMLP = 1024, OFF_Q = 2048, OFF_K = 3072, OFF_V = 4096, OFF_F = 5120, N_IN = 5128;
constexpr int ZW = 5120;
constexpr int NE = 64, TOPK = 8, DE = 512, DPLE = 256;
constexpr float ALPHA = 1.41421356237309515f;
constexpr float LN_EPS = 1e-5f, ROUTE_SCALE = 2.5f;
constexpr int NPH = 1 + 8 * DEPTH;

constexpr size_t MiB = 1u << 20;
constexpr size_t WS_CTL = 0, CTL_BYTES = 1 * MiB;
constexpr size_t WS_ASG = 1 * MiB, WS_GATE = 2 * MiB, WS_F = 3 * MiB, WS_TOKL = 4 * MiB;
constexpr size_t WS_PB = 12 * MiB, WS_W = 44 * MiB, WS_X = 476 * MiB, WS_H = 604 * MiB, WS_BIG = 894 * MiB, WS_END = 1918 * MiB;
constexpr size_t BIG_Z = 0, BIG_Y = 320 * MiB, BIG_PE = 448 * MiB;
constexpr int CW_BAR = 4096, CW_CNT = 16384;

constexpr int LDS_BYTES = 147456, MISC_OFF = 145408;

__device__ __forceinline__ float bf2f(bf16_t h) { return __uint_as_float(((unsigned)h) << 16); }
__device__ __forceinline__ float bflo(unsigned u) { return __uint_as_float(u << 16); }
__device__ __forceinline__ float bfhi(unsigned u) { return __uint_as_float(u & 0xffff0000u); }
__device__ __forceinline__ unsigned f2bf(float f) { unsigned u = __float_as_uint(f); return (u + 0x7fffu + ((u >> 16) & 1u)) >> 16; }
__device__ __forceinline__ unsigned pk2(float lo, float hi) { return f2bf(lo) | (f2bf(hi) << 16); }
__device__ __forceinline__ float sigmoidf_(float x) { return 1.0f / (1.0f + __expf(-x)); }
__device__ __forceinline__ float gelu_tanh(float x) { const float u = 0.7978845608028654f * (x + 0.044715f * x * x * x); return 0.5f * x * (1.0f + tanhf(u)); }
__device__ __forceinline__ float wave_sum(float v) {
#pragma unroll
    for (int o = 1; o < 64; o <<= 1) v += __shfl_xor(v, o);
    return v;
}
__device__ __forceinline__ float wave_max(float v) {
#pragma unroll
    for (int o = 1; o < 64; o <<= 1) v = fmaxf(v, __shfl_xor(v, o));
    return v;
}

#define XB_TMO      128
#define XB_XCNT(j)  (256  + 64 * (j))
#define XB_XSUB(j)  (1280 + 64 * (j))
#define XB_XGEN(j)  (2304 + 64 * (j))
#define XB_TOP      3328
#define XB_TOPGEN   3392
#define XCD_BAR_WORDS 3456
#define XB_SPIN_CAP (1u << 22)
__device__ __forceinline__ unsigned xb_ld(unsigned* p)              { return __hip_atomic_load(p, __ATOMIC_RELAXED, __HIP_MEMORY_SCOPE_AGENT); }
__device__ __forceinline__ unsigned xb_add(unsigned* p, unsigned v) { return __hip_atomic_fetch_add(p, v, __ATOMIC_RELAXED, __HIP_MEMORY_SCOPE_AGENT); }
__device__ __forceinline__ unsigned xb_xcc_id() { return (unsigned)__builtin_amdgcn_s_getreg((3 << 11) | 20) & 0xFu; }
#define XB_SPIN(cond, bar) do { unsigned _sp = 0; while (cond) { __builtin_amdgcn_s_sleep(1); \
    if ((++_sp & 255u) == 0u) { if (xb_ld(&(bar)[XB_TMO])) break; if (_sp > XB_SPIN_CAP) { atomicAdd(&(bar)[XB_TMO], 1u); break; } } } } while (0)
struct XcdBarrier { unsigned* bar; unsigned x; volatile LAS unsigned* st; };
__device__ __forceinline__ XcdBarrier xcd_barrier_post(unsigned* bar, volatile LAS unsigned* st) {
    XcdBarrier b; b.bar = bar; b.x = xb_xcc_id(); b.st = st;
    if (threadIdx.x == 0) (void)xb_add(&bar[XB_XCNT(b.x)], 1u);
    return b;
}
__device__ __forceinline__ void xcd_barrier_complete(unsigned* bar, unsigned x, unsigned& nloc, unsigned& nx) {
    const unsigned G = gridDim.x * gridDim.y * gridDim.z;
    unsigned sum, cnt, mine, sp = 0u;
    for (;;) {
        sum = 0u; cnt = 0u; mine = 0u;
#pragma unroll
        for (unsigned j = 0; j < 16; ++j) { const unsigned c = xb_ld(&bar[XB_XCNT(j)]); sum += c; cnt += (c > 0u) ? 1u : 0u; mine = (j == x) ? c : mine; }
        if (sum == G) break;
        __builtin_amdgcn_s_sleep(1);
        if ((++sp & 255u) == 0u) { if (xb_ld(&bar[XB_TMO])) break; if (sp > XB_SPIN_CAP) { atomicAdd(&bar[XB_TMO], 1u); break; } }
    }
    nloc = mine > 0u ? mine : 1u; nx = cnt > 0u ? cnt : 1u;
}
__device__ __forceinline__ void xcd_barrier(const XcdBarrier& b) {
    asm volatile("s_waitcnt vmcnt(0)" ::: "memory");
    __syncthreads();
    if (threadIdx.x == 0) {
        unsigned* bar = b.bar;
        __builtin_amdgcn_s_waitcnt(0);
        unsigned nloc = b.st[0], nx = b.st[1];
        if (nloc == 0u) { xcd_barrier_complete(bar, b.x, nloc, nx); b.st[0] = nloc; b.st[1] = nx; }
        const unsigned old = xb_add(&bar[XB_XSUB(b.x)], 1u);
        const unsigned gen = old / nloc;
        if (old + 1u == (gen + 1u) * nloc) {
            __builtin_amdgcn_fence(__ATOMIC_RELEASE, "agent");
            asm volatile("s_waitcnt vmcnt(0)" ::: "memory");
            const unsigned og = xb_add(&bar[XB_TOP], 1u);
            const unsigned tg = og / nx;
            if (og + 1u == (tg + 1u) * nx) xb_add(&bar[XB_TOPGEN], 1u);
            else XB_SPIN(xb_ld(&bar[XB_TOPGEN]) == tg, bar);
            __builtin_amdgcn_fence(__ATOMIC_ACQUIRE, "agent");
            xb_add(&bar[XB_XGEN(b.x)], 1u);
            asm volatile("s_waitcnt vmcnt(0)" ::: "memory");
        } else {
            XB_SPIN(xb_ld(&bar[XB_XGEN(b.x)]) == gen, bar);
            __builtin_amdgcn_fence(__ATOMIC_ACQUIRE, "agent");
            asm volatile("s_waitcnt vmcnt(0)" ::: "memory");
        }
    }
    __syncthreads();
}

template <bool DUAL, bool ABF16, class Epi>
__device__ __forceinline__ void sgemm_unit(const int tid, LAS float* sm, const void* arow, const float* B, const float* B2, int ldb, int n0, int Nlim, int K, const Epi& epi) {
    LAS float* As = sm; LAS float* Bs = sm + 16 * 132; LAS float* B2s = Bs + 16 * 128;
    const int ar = tid >> 2, ak = (tid & 3) * 4, bk = tid >> 5, bn = (tid & 31) * 4, ty = tid >> 4, tx = tid & 15;
    const bool bvalid = (n0 + bn) < Nlim;
    float acc[4][8], acc2[4][8];
#pragma unroll
    for (int i = 0; i < 4; ++i)
#pragma unroll
        for (int j = 0; j < 8; ++j) { acc[i][j] = 0.f; acc2[i][j] = 0.f; }
    float4 ra, rb, rb2; rb2 = make_float4(0.f, 0.f, 0.f, 0.f);
#define SG_LOAD(k0) do { \
        if (ABF16) { const uint2 t_ = *(const uint2*)((const bf16_t*)arow + (k0) + ak); ra.x = bflo(t_.x); ra.y = bfhi(t_.x); ra.z = bflo(t_.y); ra.w = bfhi(t_.y); } \
        else { ra = *(const float4*)((const float*)arow + (k0) + ak); } \
        rb = bvalid ? *(const float4*)(B + (size_t)((k0) + bk) * ldb + n0 + bn) : make_float4(0.f, 0.f, 0.f, 0.f); \
        if (DUAL) rb2 = bvalid ? *(const float4*)(B2 + (size_t)((k0) + bk) * ldb + n0 + bn) : make_float4(0.f, 0.f, 0.f, 0.f); } while (0)
    SG_LOAD(0);
    for (int k0 = 0; k0 < K; k0 += 16) {
        As[(ak + 0) * 132 + ar] = ra.x; As[(ak + 1) * 132 + ar] = ra.y; As[(ak + 2) * 132 + ar] = ra.z; As[(ak + 3) * 132 + ar] = ra.w;
        *(LAS f32x4*)(Bs + bk * 128 + bn) = (f32x4){rb.x, rb.y, rb.z, rb.w};
        if (DUAL) *(LAS f32x4*)(B2s + bk * 128 + bn) = (f32x4){rb2.x, rb2.y, rb2.z, rb2.w};
        __syncthreads();
        if (k0 + 16 < K) SG_LOAD(k0 + 16);
#pragma unroll 2
        for (int k = 0; k < 16; ++k) {
            const f32x4 a = *(const LAS f32x4*)(As + k * 132 + ty * 4);
            const f32x4 b0 = *(const LAS f32x4*)(Bs + k * 128 + tx * 8), b1 = *(const LAS f32x4*)(Bs + k * 128 + tx * 8 + 4);
            const float av[4] = {a.x, a.y, a.z, a.w}; const float bv[8] = {b0.x, b0.y, b0.z, b0.w, b1.x, b1.y, b1.z, b1.w};
#pragma unroll
            for (int i = 0; i < 4; ++i)
#pragma unroll
                for (int j = 0; j < 8; ++j) acc[i][j] = fmaf(av[i], bv[j], acc[i][j]);
            if (DUAL) {
                const f32x4 c0 = *(const LAS f32x4*)(B2s + k * 128 + tx * 8), c1 = *(const LAS f32x4*)(B2s + k * 128 + tx * 8 + 4);
                const float cv[8] = {c0.x, c0.y, c0.z, c0.w, c1.x, c1.y, c1.z, c1.w};
#pragma unroll
                for (int i = 0; i < 4; ++i)
#pragma unroll
                    for (int j = 0; j < 8; ++j) acc2[i][j] = fmaf(av[i], cv[j], acc2[i][j]);
            }
        }
        __syncthreads();
    }
#undef SG_LOAD
#pragma unroll
    for (int i = 0; i < 4; ++i) epi(ty * 4 + i, tx * 8, acc[i], acc2[i]);
}

__device__ __forceinline__ void store8_bf16(bf16_t* p, const float (&v)[8]) {
    uint4 o; o.x = pk2(v[0], v[1]); o.y = pk2(v[2], v[3]); o.z = pk2(v[4], v[5]); o.w = pk2(v[6], v[7]);
    *(uint4*)p = o;
}

struct Args { const float* in[29]; float* out; unsigned char* ws; int ph_lo, ph_hi; };

__global__ void __launch_bounds__(512, 2) fwd_kernel(Args a) {
    extern __shared__ __attribute__((aligned(16))) unsigned char lds_raw[];
    LAS unsigned char* lds = (LAS unsigned char*)lds_raw;
    LAS float* ldsf = (LAS float*)lds;
    volatile LAS unsigned* MISC = (volatile LAS unsigned*)(lds + MISC_OFF);
    const int tid0 = threadIdx.x;
    const int wg = blockIdx.x, nwg = gridDim.x;
#define PHASE_IDS int tid = tid0; asm volatile("" : "+v"(tid)); const int lane = tid & 63, wave = __builtin_amdgcn_readfirstlane(tid >> 6); (void)lane; (void)wave;
    unsigned char* ws = a.ws;
    unsigned* ctl = (unsigned*)(ws + WS_CTL);
    int* ASG = (int*)(ws + WS_ASG); float* GATE = (float*)(ws + WS_GATE); float* FL = (float*)(ws + WS_F); int* TOKL = (int*)(ws + WS_TOKL);
    bf16_t* XB = (bf16_t*)(ws + WS_X); bf16_t* HB = (bf16_t*)(ws + WS_H);
    bf16_t* Z = (bf16_t*)(ws + WS_BIG + BIG_Z); bf16_t* Y = (bf16_t*)(ws + WS_BIG + BIG_Y); bf16_t* PE = (bf16_t*)(ws + WS_BIG + BIG_PE); bf16_t* Y2 = (bf16_t*)(ws + WS_BIG);
    float* U1 = a.out;

    if (tid0 < 32) MISC[tid0] = 0u;
    __syncthreads();
    const int lo = a.ph_lo, hi = a.ph_hi;
    XcdBarrier bar; bar.bar = ctl + CW_BAR; bar.x = 0; bar.st = MISC + 8;
    if (hi - lo > 1) bar = xcd_barrier_post(ctl + CW_BAR, MISC + 8);
#ifndef PHMASK
#define PHMASK 0x1ff
#endif
#define IN(k) ((((PHMASK) >> ((k) == 0 ? 0 : 1 + ((k) - 1) % 8)) & 1) && lo <= (k) && (k) < hi)
#define SEAM(k) do { if ((k) + 1 < hi) xcd_barrier(bar); } while (0)

    if (IN(0)) {
        PHASE_IDS
        const float4* x4 = (const float4*)a.in[0]; uint2* o2 = (uint2*)XB;
        for (size_t i = (size_t)wg * 512 + tid; i < (size_t)T * D / 4; i += (size_t)nwg * 512) { const float4 v = x4[i]; uint2 o; o.x = pk2(v.x, v.y); o.y = pk2(v.z, v.w); o2[i] = o; }
        SEAM(0);
    }

#define w_in (a.in[2] + (size_t)l * D * N_IN)
#define b_f (a.in[3] + l * AH)
#define conv_w (a.in[4] + (size_t)l * CONV_W * CONV_CH)
#define conv_b (a.in[5] + l * CONV_CH)
#define conv_ln_g (a.in[6] + l * CONV_CH)
#define conv_ln_b (a.in[7] + l * CONV_CH)
#define gm_ln_g (a.in[8] + l * GM_CH)
#define gm_ln_b (a.in[9] + l * GM_CH)
#define w_sp (a.in[10] + (size_t)l * 4 * CHUNK * CHUNK)
#define b_sp (a.in[11] + l * 4 * CHUNK)
#define out_g (a.in[12] + l * D)
#define w_o (a.in[13] + (size_t)l * D * D)
#define ln1_g (a.in[14] + l * D)
#define ln1_b (a.in[15] + l * D)
#define w_r (a.in[16] + (size_t)l * D * NE)
#define r_bias (a.in[17] + l * NE)
#define w_e1 (a.in[18] + (size_t)l * NE * D * DE)
#define w_e3 (a.in[19] + (size_t)l * NE * D * DE)
#define w_e2 (a.in[20] + (size_t)l * NE * DE * D)
#define w_sh1 (a.in[21] + (size_t)l * D * DE)
#define w_sh3 (a.in[22] + (size_t)l * D * DE)
#define w_sh2 (a.in[23] + (size_t)l * DE * D)
#define w_pe (a.in[24] + (size_t)l * DPLE * D)
#define w_pg (a.in[25] + (size_t)l * D * D)
#define b_pg (a.in[26] + l * D)
#define ln2_g (a.in[27] + l * D)
#define ln2_b (a.in[28] + l * D)
#define pin (a.in[1] + (size_t)l * T * DPLE)
    for (int l = 0; l < DEPTH; ++l) {
        const int pb = 1 + 8 * l;
        unsigned* cntg = ctl + CW_CNT + l * 64 * 64;

        if (IN(pb + 0)) {
            PHASE_IDS
            constexpr int NTN = (N_IN + 127) / 128;
            for (int u = wg; u < (T / 128) * NTN; u += nwg) {
                const int pm = u / NTN, pn = u % NTN, n0 = pn * 128, r0 = pm * 128;
                auto epi = [&](int r, int c0, const float (&v)[8], const float (&)[8]) {
                    const int row = r0 + r, col = n0 + c0;
                    if (col < ZW) {
                        float o[8];
#pragma unroll
                        for (int j = 0; j < 8; ++j) o[j] = (col >= OFF_GMLP && col < OFF_Q) ? gelu_tanh(v[j]) : v[j];
                        store8_bf16(Z + (size_t)row * ZW + col, o);
                    } else if (col < N_IN) {
#pragma unroll
                        for (int j = 0; j < 8; ++j) FL[(size_t)row * 8 + j] = v[j];
                    }
                };
                sgemm_unit<false, true>(tid, ldsf, XB + (size_t)(r0 + (tid >> 2)) * D, w_in, nullptr, N_IN, n0, N_IN, D, epi);
            }
            SEAM(pb + 0);
        }

        if (IN(pb + 1)) {
            PHASE_IDS
            constexpr int NATT = NB * AH * (S / 64), NGM = NB * (S / CHUNK), NCV = T / 32;
            for (int u = wg; u < NATT; u += nwg) {
                __syncthreads();
                {
                    const int qblk = 63 - u / 64, bh = u % 64, b = bh >> 3, h = bh & 7;
                    LAS float* cs = ldsf;
                    LAS float* Kt = ldsf + 4096;
                    LAS float* Vs = Kt + 128 * 65;
                    LAS float* qs = Vs + 64 * 128;
                    LAS float* wtot = qs + 64 * 128;
                    const int nkeys = (qblk + 1) * 64;
                    {
                        const float bfh = b_f[h]; float loc[8]; float run = 0.f;
#pragma unroll
                        for (int j = 0; j < 8; ++j) { const int pos = tid * 8 + j; float ls = 0.f;
                            if (pos < nkeys) { const float x = FL[((size_t)b * S + pos) * 8 + h] + bfh; ls = fminf(x, 0.f) - log1pf(__expf(-fabsf(x))); }
                            run += ls; loc[j] = run; }
                        float v = run;
#pragma unroll
                        for (int o = 1; o < 64; o <<= 1) { const float n = __shfl_up(v, o); if (lane >= o) v += n; }
                        if (lane == 63) wtot[wave] = v;
                        __syncthreads();
                        float woff = 0.f; for (int w2 = 0; w2 < wave; ++w2) woff += wtot[w2];
                        const float off = woff + v - run;
#pragma unroll
                        for (int j = 0; j < 8; ++j) cs[tid * 8 + j] = loc[j] + off;
                    }
                    {
                        const int r = tid >> 3, d0 = (tid & 7) * 16; const bf16_t* qp = Z + ((size_t)b * S + qblk * 64 + r) * ZW + OFF_Q + h * HD + d0;
#pragma unroll
                        for (int j = 0; j < 16; ++j) qs[r * 128 + d0 + j] = bf2f(qp[j]) * 0.08838834764831845f;
                    }
                    float m[8], lsum[8], o0[8], o1[8];
#pragma unroll
                    for (int r = 0; r < 8; ++r) { m[r] = -1e30f; lsum[r] = 0.f; o0[r] = 0.f; o1[r] = 0.f; }
#pragma unroll 1
                    for (int kt = 0; kt <= qblk; ++kt) {
                        __syncthreads();
                        {
                            const int key = tid >> 3, d0 = (tid & 7) * 16; const size_t rowoff = ((size_t)b * S + kt * 64 + key) * ZW + h * HD + d0;
                            const bf16_t* kp = Z + rowoff + OFF_K; const bf16_t* vp = Z + rowoff + OFF_V;
#pragma unroll
                            for (int j = 0; j < 16; ++j) { Kt[(d0 + j) * 65 + key] = bf2f(kp[j]); Vs[key * 128 + d0 + j] = bf2f(vp[j]); }
                        }
                        __syncthreads();
                        float sc[8];
#pragma unroll
                        for (int r = 0; r < 8; ++r) sc[r] = 0.f;
#pragma unroll 2
                        for (int d = 0; d < 128; d += 4) {
                            const float k0 = Kt[(d + 0) * 65 + lane], k1 = Kt[(d + 1) * 65 + lane], k2 = Kt[(d + 2) * 65 + lane], k3 = Kt[(d + 3) * 65 + lane];
#pragma unroll
                            for (int r = 0; r < 8; ++r) { const f32x4 q4 = *(const LAS f32x4*)(qs + (wave * 8 + r) * 128 + d);
                                sc[r] = fmaf(q4.x, k0, sc[r]); sc[r] = fmaf(q4.y, k1, sc[r]); sc[r] = fmaf(q4.z, k2, sc[r]); sc[r] = fmaf(q4.w, k3, sc[r]); }
                        }
                        const int kpos = kt * 64 + lane; const float ck = cs[kpos];
                        float p[8];
#pragma unroll
                        for (int r = 0; r < 8; ++r) {
                            const int t = qblk * 64 + wave * 8 + r;
                            float s = sc[r] + (cs[t] - ck); if (kpos > t) s = -__builtin_inff();
                            const float mn = fmaxf(m[r], wave_max(s));
                            const float pe = __expf(s - mn), al = __expf(m[r] - mn);
                            lsum[r] = lsum[r] * al + wave_sum(pe); o0[r] *= al; o1[r] *= al; m[r] = mn; p[r] = pe;
                        }
#pragma unroll 2
                        for (int j = 0; j < 64; ++j) {
                            const f32x2 v2 = *(const LAS f32x2*)(Vs + j * 128 + 2 * lane);
#pragma unroll
                            for (int r = 0; r < 8; ++r) { const float pj = __shfl(p[r], j); o0[r] = fmaf(pj, v2.x, o0[r]); o1[r] = fmaf(pj, v2.y, o1[r]); }
                        }
                    }
#pragma unroll
                    for (int r = 0; r < 8; ++r) { const int t = qblk * 64 + wave * 8 + r; const float il = 1.0f / lsum[r];
                        *(unsigned*)(Y + ((size_t)b * S + t) * D + 1024 + h * HD + 2 * lane) = pk2(o0[r] * il, o1[r] * il); }
                }
            }
            for (int u = NATT + wg; u < NATT + NGM; u += nwg) {
                __syncthreads();
                {
                    const int ug = u - NATT, b = ug / (S / CHUNK), n = ug % (S / CHUNK); const size_t row0 = (size_t)b * S + n * CHUNK;
                    LAS float* vs = ldsf;
                    LAS float* st = ldsf + 128 * 128;
#pragma unroll 1
                    for (int i = 0; i < 16; ++i) { const int s = wave * 16 + i; const bf16_t* vp = Z + (row0 + s) * ZW + 1536;
                        float x[8]; float sum = 0.f;
#pragma unroll
                        for (int j = 0; j < 8; ++j) { x[j] = bf2f(vp[lane + 64 * j]); sum += x[j]; }
                        const float mean = wave_sum(sum) * (1.f / 512.f); float q = 0.f;
#pragma unroll
                        for (int j = 0; j < 8; ++j) { const float dd = x[j] - mean; q += dd * dd; }
                        const float rstd = rsqrtf(wave_sum(q) * (1.f / 512.f) + LN_EPS);
                        if (lane == 0) { st[s * 2] = mean; st[s * 2 + 1] = rstd; } }
                    __syncthreads();
                    for (int h = 0; h < 4; ++h) {
                        { const int c = tid & 127, sg = tid >> 7; const float g = gm_ln_g[h * 128 + c], bb = gm_ln_b[h * 128 + c];
#pragma unroll 2
                          for (int i = 0; i < 32; ++i) { const int s = sg + 4 * i; vs[s * 128 + c] = (bf2f(Z[(row0 + s) * ZW + 1536 + h * 128 + c]) - st[s * 2]) * st[s * 2 + 1] * g + bb; } }
                        __syncthreads();
                        { const int c = tid & 127, tg = tid >> 7;
#pragma unroll 1
                          for (int i = 0; i < 32; ++i) { const int t = tg * 32 + i; const float* wrow = w_sp + ((size_t)(h * 128 + t)) * 128; float acc = 0.f;
#pragma unroll 4
                              for (int s = 0; s <= t; ++s) acc = fmaf(wrow[s], vs[s * 128 + c], acc);
                              const float uu = bf2f(Z[(row0 + t) * ZW + 1024 + h * 128 + c]);
                              Y[(row0 + t) * D + 512 + h * 128 + c] = (bf16_t)f2bf(uu * (acc + b_sp[h * 128 + t])); } }
                        __syncthreads();
                    }
                }
            }
            for (int u = NATT + NGM + wg; u < NATT + NGM + NCV; u += nwg) {
                __syncthreads();
                {
                    const int uc = u - NATT - NGM, b = uc / (S / 32), s0 = (uc % (S / 32)) * 32; const int c = tid;
                    LAS float* hs = ldsf;
#pragma unroll 2
                    for (int i = 0; i < 62; ++i) { const int t = s0 - 30 + i; float hv = 0.f;
                        if (t >= 0) { const bf16_t* zp = Z + ((size_t)b * S + t) * ZW; hv = bf2f(zp[c]) * sigmoidf_(bf2f(zp[512 + c])); }
                        hs[i * 512 + c] = hv; }
                    float wv[31];
#pragma unroll
                    for (int j = 0; j < 31; ++j) wv[j] = conv_w[j * 512 + c];
                    const float cb = conv_b[c];
#pragma unroll 1
                    for (int t = 0; t < 32; ++t) { float acc = cb;
#pragma unroll
                        for (int j = 0; j < 31; ++j) acc = fmaf(wv[j], hs[(t + j) * 512 + c], acc);
                        hs[t * 512 + c] = acc; }
                    __syncthreads();
#pragma unroll 1
                    for (int i = 0; i < 4; ++i) { const int t = wave * 4 + i; float x[8]; float sum = 0.f;
#pragma unroll
                        for (int j = 0; j < 8; ++j) { x[j] = hs[t * 512 + lane + 64 * j]; sum += x[j]; }
                        const float mean = wave_sum(sum) * (1.f / 512.f); float q = 0.f;
#pragma unroll
                        for (int j = 0; j < 8; ++j) { const float dd = x[j] - mean; q += dd * dd; }
                        const float rstd = rsqrtf(wave_sum(q) * (1.f / 512.f) + LN_EPS); float ss = 0.f;
#pragma unroll
                        for (int j = 0; j < 8; ++j) { const int cc = lane + 64 * j; const float yv = (x[j] - mean) * rstd * conv_ln_g[cc] + conv_ln_b[cc]; x[j] = yv * sigmoidf_(yv); ss += x[j] * x[j]; }
                        const float rr = rsqrtf(wave_sum(ss) * (1.f / 512.f) + LN_EPS);
#pragma unroll
                        for (int j = 0; j < 8; ++j) { const int cc = lane + 64 * j; Y[((size_t)b * S + s0 + t) * D + cc] = (bf16_t)f2bf(x[j] * rr * out_g[cc]); } }
                }
            }
            SEAM(pb + 1);
        }

        if (IN(pb + 2)) {
            PHASE_IDS
            for (int row = wg * 8 + wave; row < T; row += nwg * 8) {
                bf16_t* yr = Y + (size_t)row * D;
                float xb[8], xc[16]; float sb = 0.f, scs = 0.f;
#pragma unroll
                for (int j = 0; j < 8; ++j) { xb[j] = bf2f(yr[512 + lane + 64 * j]); sb += xb[j] * xb[j]; }
#pragma unroll
                for (int j = 0; j < 16; ++j) { xc[j] = bf2f(yr[1024 + lane + 64 * j]); scs += xc[j] * xc[j]; }
                const float rb = rsqrtf(wave_sum(sb) * (1.f / 512.f) + LN_EPS), rc = rsqrtf(wave_sum(scs) * (1.f / 1024.f) + LN_EPS);
#pragma unroll
                for (int j = 0; j < 8; ++j) { const int cc = 512 + lane + 64 * j; yr[cc] = (bf16_t)f2bf(xb[j] * rb * out_g[cc]); }
#pragma unroll
                for (int j = 0; j < 16; ++j) { const int cc = 1024 + lane + 64 * j; yr[cc] = (bf16_t)f2bf(xc[j] * rc * out_g[cc]); }
            }
            SEAM(pb + 2);
        }

        if (IN(pb + 3)) {
            PHASE_IDS
            constexpr int NU = (T / 128) * (D / 128);
            for (int u = wg; u < 2 * NU; u += nwg) {
                const int uu = u % NU, pm = uu / (D / 128), pn = uu % (D / 128), n0 = pn * 128, r0 = pm * 128;
                if (u < NU) {
                    auto epi = [&](int r, int c0, const float (&v)[8], const float (&)[8]) {
                        const size_t o = (size_t)(r0 + r) * D + n0 + c0; const uint4 xv = *(const uint4*)(XB + o);
                        float4 o0, o1; o0.x = ALPHA * bflo(xv.x) + v[0]; o0.y = ALPHA * bfhi(xv.x) + v[1]; o0.z = ALPHA * bflo(xv.y) + v[2]; o0.w = ALPHA * bfhi(xv.y) + v[3];
                        o1.x = ALPHA * bflo(xv.z) + v[4]; o1.y = ALPHA * bfhi(xv.z) + v[5]; o1.z = ALPHA * bflo(xv.w) + v[6]; o1.w = ALPHA * bfhi(xv.w) + v[7];
                        *(float4*)(U1 + o) = o0; *(float4*)(U1 + o + 4) = o1; };
                    sgemm_unit<false, true>(tid, ldsf, Y + (size_t)(r0 + (tid >> 2)) * D, w_o, nullptr, D, n0, D, D, epi);
                } else {
                    auto epi = [&](int r, int c0, const float (&v)[8], const float (&)[8]) { store8_bf16(PE + (size_t)(r0 + r) * D + n0 + c0, v); };
                    sgemm_unit<false, false>(tid, ldsf, pin + (size_t)(r0 + (tid >> 2)) * DPLE, w_pe, nullptr, D, n0, D, DPLE, epi);
                }
            }
            SEAM(pb + 3);
        }

        if (IN(pb + 4)) {
            PHASE_IDS
            LAS float* xs = ldsf;
            LAS int* lcnt = (LAS int*)(lds + 131072);
            LAS int* lbase = lcnt + 64;
            for (int tile = wg; tile < T / 16; tile += nwg) {
                const int t0 = tile * 16;
                __syncthreads();
                if (tid < 64) lcnt[tid] = 0;
                for (int rr = 0; rr < 2; ++rr) { const int lr = wave * 2 + rr; const size_t row = (size_t)t0 + lr;
                    float4 v[8]; float sum = 0.f;
#pragma unroll
                    for (int j = 0; j < 8; ++j) { v[j] = *(const float4*)(U1 + row * D + (j * 64 + lane) * 4); sum += (v[j].x + v[j].y) + (v[j].z + v[j].w); }
                    const float mean = wave_sum(sum) * (1.f / D); float q = 0.f;
#pragma unroll
                    for (int j = 0; j < 8; ++j) { v[j].x -= mean; v[j].y -= mean; v[j].z -= mean; v[j].w -= mean; q += (v[j].x * v[j].x + v[j].y * v[j].y) + (v[j].z * v[j].z + v[j].w * v[j].w); }
                    const float rstd = rsqrtf(wave_sum(q) * (1.f / D) + LN_EPS);
#pragma unroll
                    for (int j = 0; j < 8; ++j) { const int c = (j * 64 + lane) * 4; const float4 g = *(const float4*)(ln1_g + c), bb = *(const float4*)(ln1_b + c);
                        float4 y; y.x = v[j].x * rstd * g.x + bb.x; y.y = v[j].y * rstd * g.y + bb.y; y.z = v[j].z * rstd * g.z + bb.z; y.w = v[j].w * rstd * g.w + bb.w;
                        uint2 o; o.x = pk2(y.x, y.y); o.y = pk2(y.z, y.w); *(uint2*)(XB + row * D + c) = o;
                        float4 yr; yr.x = bflo(o.x); yr.y = bfhi(o.x); yr.z = bflo(o.y); yr.w = bfhi(o.y);
                        *(LAS f32x4*)(xs + lr * D + c) = (f32x4){yr.x, yr.y, yr.z, yr.w}; } }
                __syncthreads();
                float acc0 = 0.f, acc1 = 0.f;
                { const LAS float* x0 = xs + (wave * 2) * D; const LAS float* x1 = x0 + D; const float* wp = w_r + lane;
                  for (int k = 0; k < D; k += 4) { const f32x4 a0 = *(const LAS f32x4*)(x0 + k), a1 = *(const LAS f32x4*)(x1 + k);
                      const float w0 = wp[(size_t)(k + 0) * NE], w1 = wp[(size_t)(k + 1) * NE], w2 = wp[(size_t)(k + 2) * NE], w3 = wp[(size_t)(k + 3) * NE];
                      acc0 = fmaf(a0.x, w0, acc0); acc0 = fmaf(a0.y, w1, acc0); acc0 = fmaf(a0.z, w2, acc0); acc0 = fmaf(a0.w, w3, acc0);
                      acc1 = fmaf(a1.x, w0, acc1); acc1 = fmaf(a1.y, w1, acc1); acc1 = fmaf(a1.z, w2, acc1); acc1 = fmaf(a1.w, w3, acc1); } }
                const float rbias = r_bias[lane];
                bool ch[2]; int erk[2], lp[2]; float gt[2];
#pragma unroll
                for (int rr = 0; rr < 2; ++rr) {
                    const float score = sigmoidf_(rr ? acc1 : acc0), sel = score + rbias; const int g = lane >> 3;
                    int rk = 0;
#pragma unroll
                    for (int j = 1; j < 8; ++j) { const float o = __shfl_xor(sel, j); const int ol = lane ^ j; rk += (o > sel || (o == sel && ol < lane)) ? 1 : 0; }
                    float gs = rk < 2 ? sel : 0.f; gs += __shfl_xor(gs, 1); gs += __shfl_xor(gs, 2); gs += __shfl_xor(gs, 4);
                    int grk = 0;
#pragma unroll
                    for (int j = 1; j < 8; ++j) { const float o = __shfl_xor(gs, j * 8); const int og = g ^ j; grk += (o > gs || (o == gs && og < g)) ? 1 : 0; }
                    const bool gsel = grk < 4; const float msel = gsel ? sel : -__builtin_inff();
                    int ek = 0;
#pragma unroll
                    for (int j = 1; j < 64; ++j) { const float o = __shfl_xor(msel, j); const int ol = lane ^ j; ek += (o > msel || (o == msel && ol < lane)) ? 1 : 0; }
                    ch[rr] = gsel && ek < TOPK; erk[rr] = ek;
                    const float gsum = wave_sum(ch[rr] ? score : 0.f); gt[rr] = score / gsum * ROUTE_SCALE;
                    lp[rr] = 0; if (ch[rr]) lp[rr] = atomicAdd((int*)(lcnt + lane), 1);
                }
                __syncthreads();
                if (tid < 64) { const int c = lcnt[tid]; int bs = 0; if (c > 0) bs = (int)atomicAdd(cntg + tid * 64, (unsigned)c); lbase[tid] = bs; }
                __syncthreads();
#pragma unroll
                for (int rr = 0; rr < 2; ++rr) if (ch[rr]) { const int tok = t0 + wave * 2 + rr, pos = lbase[lane] + lp[rr];
                    TOKL[lane * T + pos] = tok; ASG[tok * 8 + erk[rr]] = (lane << 16) | pos; GATE[tok * 8 + erk[rr]] = gt[rr]; }
            }
            SEAM(pb + 4);
        }

        if (IN(pb + 5)) {
            PHASE_IDS
            LAS int* tl = (LAS int*)(lds + 131072);
            __syncthreads();
            if (tid == 0) { int tp = 0, rs = 0; for (int e = 0; e < NE; ++e) { const int c = (int)cntg[e * 64]; tl[e] = tp; tl[65 + e] = rs; tl[130 + e] = c; tp += (c + 127) / 128; rs += c; } tl[64] = tp; tl[129] = rs; }
            __syncthreads();
            const int ntr = tl[64];
            const int nu_r = ntr * 4, nu_s = (T / 128) * 4, nu_g = (T / 128) * (D / 128);
            for (int u = wg; u < nu_r + nu_s + nu_g; u += nwg) {
                if (u < nu_r + nu_s) {
                    const bool routed = u < nu_r; int e = 0, ti, pn, cnt_e, rs_e;
                    if (routed) { const int gt_ = u >> 2; pn = u & 3; while (e < NE - 1 && tl[e + 1] <= gt_) ++e; ti = gt_ - tl[e]; cnt_e = tl[130 + e]; rs_e = tl[65 + e]; }
                    else { const int us = u - nu_r; ti = us >> 2; pn = us & 3; cnt_e = T; rs_e = T * TOPK; }
                    const int ar = ti * 128 + (tid >> 2); const int arc = ar < cnt_e ? ar : cnt_e - 1;
                    const int tok = routed ? TOKL[e * T + arc] : arc;
                    const float* B1 = routed ? w_e1 + (size_t)e * D * DE : w_sh1; const float* B3 = routed ? w_e3 + (size_t)e * D * DE : w_sh3;
                    auto epi = [&](int r, int c0, const float (&v)[8], const float (&w)[8]) {
                        const int idx = ti * 128 + r; if (idx >= cnt_e) return; float o[8];
#pragma unroll
                        for (int j = 0; j < 8; ++j) o[j] = v[j] * sigmoidf_(v[j]) * w[j];
                        store8_bf16(HB + (size_t)(rs_e + idx) * DE + pn * 128 + c0, o); };
                    sgemm_unit<true, true>(tid, ldsf, XB + (size_t)tok * D, B1, B3, DE, pn * 128, DE, D, epi);
                } else {
                    const int ug = u - nu_r - nu_s, pm = ug / (D / 128), pn = ug % (D / 128), n0 = pn * 128, r0 = pm * 128;
                    auto epi = [&](int r, int c0, const float (&v)[8], const float (&)[8]) {
                        const size_t o = (size_t)(r0 + r) * D + n0 + c0; const uint4 xv = *(const uint4*)(XB + o), pv = *(const uint4*)(PE + o);
                        const float xx[8] = {bflo(xv.x), bfhi(xv.x), bflo(xv.y), bfhi(xv.y), bflo(xv.z), bfhi(xv.z), bflo(xv.w), bfhi(xv.w)};
                        const float pp[8] = {bflo(pv.x), bfhi(pv.x), bflo(pv.y), bfhi(pv.y), bflo(pv.z), bfhi(pv.z), bflo(pv.w), bfhi(pv.w)};
                        float r8[8];
#pragma unroll
                        for (int j = 0; j < 8; ++j) r8[j] = ALPHA * xx[j] + sigmoidf_(v[j] + b_pg[n0 + c0 + j]) * pp[j];
                        *(float4*)(U1 + o) = make_float4(r8[0], r8[1], r8[2], r8[3]); *(float4*)(U1 + o + 4) = make_float4(r8[4], r8[5], r8[6], r8[7]); };
                    sgemm_unit<false, true>(tid, ldsf, XB + (size_t)(r0 + (tid >> 2)) * D, w_pg, nullptr, D, n0, D, D, epi);
                }
            }
            SEAM(pb + 5);
        }

        if (IN(pb + 6)) {
            PHASE_IDS
            LAS int* tl = (LAS int*)(lds + 131072);
            __syncthreads();
            if (tid == 0) { int tp = 0, rs = 0; for (int e = 0; e < NE; ++e) { const int c = (int)cntg[e * 64]; tl[e] = tp; tl[65 + e] = rs; tl[130 + e] = c; tp += (c + 127) / 128; rs += c; } tl[64] = tp; tl[129] = rs; }
            __syncthreads();
            const int ntr = tl[64];
            const int nu_r = ntr * 16, nu_s = (T / 128) * 16;
            for (int u = wg; u < nu_r + nu_s; u += nwg) {
                const bool routed = u < nu_r; int e = 0, ti, pn, cnt_e, rs_e;
                if (routed) { const int gt_ = u >> 4; pn = u & 15; while (e < NE - 1 && tl[e + 1] <= gt_) ++e; ti = gt_ - tl[e]; cnt_e = tl[130 + e]; rs_e = tl[65 + e]; }
                else { const int us = u - nu_r; ti = us >> 4; pn = us & 15; cnt_e = T; rs_e = T * TOPK; }
                const int ar = ti * 128 + (tid >> 2); const int arc = ar < cnt_e ? ar : cnt_e - 1;
                const float* B2 = routed ? w_e2 + (size_t)e * DE * D : w_sh2;
                auto epi = [&](int r, int c0, const float (&v)[8], const float (&)[8]) {
                    const int idx = ti * 128 + r; if (idx >= cnt_e) return;
                    if (routed) store8_bf16(Y2 + (size_t)(rs_e + idx) * D + pn * 128 + c0, v);
                    else { float* bp = U1 + (size_t)idx * D + pn * 128 + c0; float4 b0 = *(float4*)bp, b1 = *(float4*)(bp + 4);
                        b0.x += v[0]; b0.y += v[1]; b0.z += v[2]; b0.w += v[3]; b1.x += v[4]; b1.y += v[5]; b1.z += v[6]; b1.w += v[7]; *(float4*)bp = b0; *(float4*)(bp + 4) = b1; } };
                sgemm_unit<false, true>(tid, ldsf, HB + (size_t)(rs_e + arc) * DE, B2, nullptr, D, pn * 128, D, DE, epi);
            }
            SEAM(pb + 6);
        }

        if (IN(pb + 7)) {
            PHASE_IDS
            LAS int* rsl = (LAS int*)(lds + 131072);
            __syncthreads();
            if (tid == 0) { int rs = 0; for (int e = 0; e < NE; ++e) { rsl[e] = rs; rs += (int)cntg[e * 64]; } }
            __syncthreads();
            const bool last = (l == DEPTH - 1);
            for (int row = wg * 8 + wave; row < T; row += nwg * 8) {
                float4 v[8];
#pragma unroll
                for (int j = 0; j < 8; ++j) v[j] = *(const float4*)(U1 + (size_t)row * D + (j * 64 + lane) * 4);
#pragma unroll 1
                for (int k = 0; k < TOPK; ++k) { const int as = ASG[row * 8 + k]; const float g = GATE[row * 8 + k]; const size_t slot = (size_t)rsl[as >> 16] + (as & 0xffff);
                    const bf16_t* yp = Y2 + slot * D;
#pragma unroll
                    for (int j = 0; j < 8; ++j) { const uint2 yv = *(const uint2*)(yp + (j * 64 + lane) * 4);
                        v[j].x = fmaf(g, bflo(yv.x), v[j].x); v[j].y = fmaf(g, bfhi(yv.x), v[j].y); v[j].z = fmaf(g, bflo(yv.y), v[j].z); v[j].w = fmaf(g, bfhi(yv.y), v[j].w); } }
                float sum = 0.f;
#pragma unroll
                for (int j = 0; j < 8; ++j) sum += (v[j].x + v[j].y) + (v[j].z + v[j].w);
                const float mean = wave_sum(sum) * (1.f / D); float q = 0.f;
#pragma unroll
                for (int j = 0; j < 8; ++j) { v[j].x -= mean; v[j].y -= mean; v[j].z -= mean; v[j].w -= mean; q += (v[j].x * v[j].x + v[j].y * v[j].y) + (v[j].z * v[j].z + v[j].w * v[j].w); }
                const float rstd = rsqrtf(wave_sum(q) * (1.f / D) + LN_EPS);
#pragma unroll
                for (int j = 0; j < 8; ++j) { const int c = (j * 64 + lane) * 4; const float4 g = *(const float4*)(ln2_g + c), bb = *(const float4*)(ln2_b + c);
                    float4 y; y.x = v[j].x * rstd * g.x + bb.x; y.y = v[j].y * rstd * g.y + bb.y; y.z = v[j].z * rstd * g.z + bb.z; y.w = v[j].w * rstd * g.w + bb.w;
                    if (last) *(float4*)(a.out + (size_t)row * D + c) = y;
                    else { uint2 o; o.x = pk2(y.x, y.y); o.y = pk2(y.z, y.w); *(uint2*)(XB + (size_t)row * D + c) = o; } }
            }
            SEAM(pb + 7);
        }
    }
#undef IN
#undef SEAM
#undef w_in
#undef b_f
#undef conv_w
#undef conv_b
#undef conv_ln_g
#undef conv_ln_b
#undef gm_ln_g
#undef gm_ln_b
#undef w_sp
#undef b_sp
#undef out_g
#undef w_o
#undef ln1_g
#undef ln1_b
#undef w_r
#undef r_bias
#undef w_e1
#undef w_e3
#undef w_e2
#undef w_sh1
#undef w_sh3
#undef w_sh2
#undef w_pe
#undef w_pg
#undef b_pg
#undef ln2_g
#undef ln2_b
#undef pin
}
}

#ifndef MK_ONE_LAUNCH
#define MK_ONE_LAUNCH 0
#endif

extern "C" void kernel_launch(void* const* d_in, const int* in_sizes, int n_in, void* d_out, int out_size, void* d_ws, size_t ws_size, hipStream_t stream) {
    static int grid = 0;
    if (grid == 0) {
        if (n_in != 29 || in_sizes[0] != T * D || out_size != T * D || ws_size < WS_END) {
            fprintf(stderr, "kernel_launch: unexpected shapes (n_in %d, in0 %d, out %d, ws %zu; need ws >= %zu)\n", n_in, n_in > 0 ? in_sizes[0] : -1, out_size, ws_size, (size_t)WS_END); grid = -1; return; }
        int dev = 0, cus = 0, per_cu = 0;
        if (hipGetDevice(&dev) != hipSuccess || hipDeviceGetAttribute(&cus, hipDeviceAttributeMultiprocessorCount, dev) != hipSuccess) { grid = -1; return; }
        if (hipFuncSetAttribute((const void*)fwd_kernel, hipFuncAttributeMaxDynamicSharedMemorySize, LDS_BYTES) != hipSuccess) { fprintf(stderr, "kernel_launch: hipFuncSetAttribute failed\n"); grid = -1; return; }
        if (hipOccupancyMaxActiveBlocksPerMultiprocessor(&per_cu, (const void*)fwd_kernel, 512, LDS_BYTES) != hipSuccess || per_cu < 1) { fprintf(stderr, "kernel_launch: occupancy query says %d\n", per_cu); }
        (void)hipGetLastError();
        grid = cus;
    }
    if (grid < 0) return;
    (void)hipMemsetAsync((char*)d_ws + WS_CTL, 0, CTL_BYTES, stream);
    Args a{};
    for (int i = 0; i < 29; ++i) a.in[i] = (const float*)d_in[i];
    a.out = (float*)d_out; a.ws = (unsigned char*)d_ws;
#if MK_ONE_LAUNCH
    a.ph_lo = 0; a.ph_hi = NPH;
    hipLaunchKernelGGL(fwd_kernel, dim3(grid), dim3(512), LDS_BYTES, stream, a);
#else
    for (int ph = 0; ph < NPH; ++ph) { a.ph_lo = ph; a.ph_hi = ph + 1; hipLaunchKernelGGL(fwd_kernel, dim3(grid), dim3(512), LDS_BYTES, stream, a); }
#endif
}
```

```cpp
#include <hip/hip_runtime.h>
#include <cstdio>
#include <cstdint>

#define LAS __attribute__((address_space(3)))
typedef unsigned short bf16_t;
typedef float f32x4 __attribute__((ext_vector_type(4)));
typedef float f32x2 __attribute__((ext_vector_type(2)));

namespace {
constexpr int NB = 8, S = 4096, T = NB * S, D = 2048, DEPTH = 2;
constexpr int CONV_CH = 512, CONV_W = 31, GM_CH = 512, CHUNK = 128, AH = 8, HD = 128;
constexpr int OFF_GMLP = 1024, OFF_Q = 2048, OFF_K = 3072, OFF_V = 4096, OFF_F = 5120, N_IN = 5128;
constexpr int YC_ATT = 0, YC_CONV = 1024, YC_GMLP = 1536;
constexpr int ZW = 5120;
constexpr int NE = 64, TOPK = 8, DE = 512, DPLE = 256;
constexpr float ALPHA = 1.41421356237309515f;
constexpr float LN_EPS = 1e-5f, ROUTE_SCALE = 2.5f;
constexpr int PPL = 9;
constexpr int NPH = 1 + PPL * DEPTH;

constexpr size_t MiB = 1u << 20;
constexpr size_t WS_CTL = 0, CTL_BYTES = 1 * MiB;
constexpr size_t WS_ASG = 1 * MiB, WS_GATE = 2 * MiB, WS_F = 3 * MiB, WS_TOKL = 4 * MiB;
constexpr size_t WS_PB = 12 * MiB, WS_W = 44 * MiB, WS_X = 476 * MiB, WS_H = 604 * MiB, WS_BIG = 894 * MiB, WS_BASE = 1918 * MiB, WS_END = 2046 * MiB, WS_XB8 = WS_H + 160 * MiB;
constexpr size_t BIG_Z = 0, BIG_Y = 320 * MiB, BIG_PE = 448 * MiB;
constexpr size_t WO_WIN = 0, WO_WO = WO_WIN + (size_t)ZW * D, WO_W13 = WO_WO + (size_t)D * D, WO_W2 = WO_W13 + (size_t)65 * 1024 * D,
                 WO_WPE = WO_W2 + (size_t)65 * D * DE, WO_WPG = WO_WPE + (size_t)D * DPLE, WO_WF = WO_WPG + (size_t)D * D, WO_WR = WO_WF + (size_t)8 * D, WO_WSP = WO_WR + (size_t)2 * NE * D, WO_END = WO_WSP + (size_t)4 * CHUNK * CHUNK;
constexpr size_t WS_SSQ = WS_X - 1 * MiB;
static_assert(WO_END * 2 <= WS_SSQ - WS_W, "weight copies fit the W region");
constexpr int CW_BAR = 32768, CW_BAR_STRIDE = 4096, CW_CNT = 16384;

constexpr int LDS_BYTES = 147456, MISC_OFF = 145408;

__device__ __forceinline__ float bf2f(bf16_t h) { return __uint_as_float(((unsigned)h) << 16); }
__device__ __forceinline__ float bflo(unsigned u) { return __uint_as_float(u << 16); }
__device__ __forceinline__ float bfhi(unsigned u) { return __uint_as_float(u & 0xffff0000u); }
__device__ __forceinline__ unsigned f2bf(float f) { unsigned u = __float_as_uint(f); return (u + 0x7fffu + ((u >> 16) & 1u)) >> 16; }
__device__ __forceinline__ unsigned pk2(float lo, float hi) { return f2bf(lo) | (f2bf(hi) << 16); }
#ifndef USE_FP8
#define USE_FP8 1
#endif
constexpr float W8_SCALE = 64.f, W8_INV = 1.f / 64.f, Y2_SCALE = 16.f, Y2_INV = 1.f / 16.f;
__device__ __forceinline__ unsigned pk4_fp8(float a, float b, float c, float d) { int w = __builtin_amdgcn_cvt_pk_fp8_f32(a, b, 0, false); w = __builtin_amdgcn_cvt_pk_fp8_f32(c, d, w, true); return (unsigned)w; }
__device__ __forceinline__ float sigmoidf_(float x) { return 1.0f / (1.0f + __expf(-x)); }
__device__ __forceinline__ float gelu_tanh(float x) { const float u = 0.7978845608028654f * (x + 0.044715f * x * x * x); return 0.5f * x * (1.0f + tanhf(u)); }
template <int M> __device__ __forceinline__ float swz_xor(float v) { return __int_as_float(__builtin_amdgcn_ds_swizzle(__float_as_int(v), (M << 10) | 0x1f)); }
__device__ __forceinline__ float wave_sum(float v) {
    v += swz_xor<1>(v); v += swz_xor<2>(v); v += swz_xor<4>(v); v += swz_xor<8>(v); v += swz_xor<16>(v);
    const auto rr = __builtin_amdgcn_permlane32_swap(__float_as_uint(v), __float_as_uint(v), false, false);
    return __uint_as_float(rr[0]) + __uint_as_float(rr[1]);
}
__device__ __forceinline__ float wave_max(float v) {
    v = fmaxf(v, swz_xor<1>(v)); v = fmaxf(v, swz_xor<2>(v)); v = fmaxf(v, swz_xor<4>(v)); v = fmaxf(v, swz_xor<8>(v)); v = fmaxf(v, swz_xor<16>(v));
    const auto rr = __builtin_amdgcn_permlane32_swap(__float_as_uint(v), __float_as_uint(v), false, false);
    return fmaxf(__uint_as_float(rr[0]), __uint_as_float(rr[1]));
}
template <int M> __device__ __forceinline__ float shx(float v, int lane) {
    if constexpr (M < 32) return swz_xor<M>(v);
    else { const auto rr = __builtin_amdgcn_permlane32_swap(__float_as_uint(v), __float_as_uint(v), false, false); const float w = __uint_as_float(lane < 32 ? rr[1] : rr[0]);
        if constexpr ((M & 31) != 0) return swz_xor<(M & 31)>(w); else return w; }
}
__device__ __forceinline__ float lane_up(float v, int lane, int o) { return __int_as_float(__builtin_amdgcn_ds_bpermute(((lane - o) & 63) << 2, __float_as_int(v))); }
__device__ __forceinline__ int lane_up_i(int v, int lane, int o) { return __builtin_amdgcn_ds_bpermute(((lane - o) & 63) << 2, v); }

#define XB_TMO      128
#define XB_XCNT(j)  (256  + 64 * (j))
#define XB_XSUB(j)  (1280 + 64 * (j))
#define XB_XGEN(j)  (2304 + 64 * (j))
#define XB_TOP      3328
#define XB_TOPGEN   3392
#define XCD_BAR_WORDS 3456
#define XB_SPIN_CAP (1u << 22)
__device__ __forceinline__ unsigned xb_ld(unsigned* p)              { return __hip_atomic_load(p, __ATOMIC_RELAXED, __HIP_MEMORY_SCOPE_AGENT); }
__device__ __forceinline__ unsigned xb_add(unsigned* p, unsigned v) { return __hip_atomic_fetch_add(p, v, __ATOMIC_RELAXED, __HIP_MEMORY_SCOPE_AGENT); }
__device__ __forceinline__ unsigned xb_xcc_id() { return (unsigned)__builtin_amdgcn_s_getreg((3 << 11) | 20) & 0xFu; }
#define XB_SPIN(cond, bar) do { unsigned _sp = 0; while (cond) { __builtin_amdgcn_s_sleep(1); \
    if ((++_sp & 255u) == 0u) { if (xb_ld(&(bar)[XB_TMO])) break; if (_sp > XB_SPIN_CAP) { atomicAdd(&(bar)[XB_TMO], 1u); break; } } } } while (0)
struct XcdBarrier { unsigned* bar; unsigned x; volatile LAS unsigned* st; };
__device__ __forceinline__ XcdBarrier xcd_barrier_post(unsigned* bar, volatile LAS unsigned* st) {
    XcdBarrier b; b.bar = bar; b.x = xb_xcc_id(); b.st = st;
    if (threadIdx.x == 0) (void)xb_add(&bar[XB_XCNT(b.x)], 1u);
    return b;
}
__device__ __forceinline__ void xcd_barrier_complete(unsigned* bar, unsigned x, unsigned& nloc, unsigned& nx) {
    const unsigned G = gridDim.x * gridDim.y * gridDim.z;
    unsigned sum, cnt, mine, sp = 0u;
    for (;;) {
        sum = 0u; cnt = 0u; mine = 0u;
#pragma unroll
        for (unsigned j = 0; j < 16; ++j) { const unsigned c = xb_ld(&bar[XB_XCNT(j)]); sum += c; cnt += (c > 0u) ? 1u : 0u; }
        mine = xb_ld(&bar[XB_XCNT(x)]);
        if (sum == G) break;
        __builtin_amdgcn_s_sleep(1);
        if ((++sp & 255u) == 0u) { if (xb_ld(&bar[XB_TMO])) break; if (sp > XB_SPIN_CAP) { atomicAdd(&bar[XB_TMO], 1u); break; } }
    }
    nloc = mine > 0u ? mine : 1u; nx = cnt > 0u ? cnt : 1u;
}
__device__ __forceinline__ void xcd_barrier(const XcdBarrier& b) {
    asm volatile("s_waitcnt vmcnt(0)" ::: "memory");
    __syncthreads();
    if (threadIdx.x == 0) {
        unsigned* bar = b.bar;
        __builtin_amdgcn_s_waitcnt(0);
        unsigned nloc = b.st[0], nx = b.st[1];
        if (nloc == 0u) { xcd_barrier_complete(bar, b.x, nloc, nx); b.st[0] = nloc; b.st[1] = nx; }
        const unsigned old = xb_add(&bar[XB_XSUB(b.x)], 1u);
        const unsigned gen = old / nloc;
        if (old + 1u == (gen + 1u) * nloc) {
            __builtin_amdgcn_fence(__ATOMIC_RELEASE, "agent");
            asm volatile("s_waitcnt vmcnt(0)" ::: "memory");
            const unsigned og = xb_add(&bar[XB_TOP], 1u);
            const unsigned tg = og / nx;
            if (og + 1u == (tg + 1u) * nx) xb_add(&bar[XB_TOPGEN], 1u);
            else XB_SPIN(xb_ld(&bar[XB_TOPGEN]) == tg, bar);
            __builtin_amdgcn_fence(__ATOMIC_ACQUIRE, "agent");
            xb_add(&bar[XB_XGEN(b.x)], 1u);
            asm volatile("s_waitcnt vmcnt(0)" ::: "memory");
        } else {
            XB_SPIN(xb_ld(&bar[XB_XGEN(b.x)]) == gen, bar);
            __builtin_amdgcn_fence(__ATOMIC_ACQUIRE, "agent");
            asm volatile("s_waitcnt vmcnt(0)" ::: "memory");
        }
    }
    __syncthreads();
}

template <bool DUAL, bool ABF16, class Epi>
__device__ __forceinline__ void sgemm_unit(const int tid, LAS float* sm, const void* arow, const float* B, const float* B2, int ldb, int n0, int Nlim, int K, const Epi& epi) {
    LAS float* As = sm; LAS float* Bs = sm + 16 * 132; LAS float* B2s = Bs + 16 * 128;
    const int ar = tid >> 2, ak = (tid & 3) * 4, bk = tid >> 5, bn = (tid & 31) * 4, ty = tid >> 4, tx = tid & 15;
    const bool bvalid = (n0 + bn) < Nlim;
    float acc[4][8], acc2[4][8];
#pragma unroll
    for (int i = 0; i < 4; ++i)
#pragma unroll
        for (int j = 0; j < 8; ++j) { acc[i][j] = 0.f; acc2[i][j] = 0.f; }
    float4 ra, rb, rb2; rb2 = make_float4(0.f, 0.f, 0.f, 0.f);
#define SG_LOAD(k0) do { \
        if (ABF16) { const uint2 t_ = *(const uint2*)((const bf16_t*)arow + (k0) + ak); ra.x = bflo(t_.x); ra.y = bfhi(t_.x); ra.z = bflo(t_.y); ra.w = bfhi(t_.y); } \
        else { ra = *(const float4*)((const float*)arow + (k0) + ak); } \
        rb = bvalid ? *(const float4*)(B + (size_t)((k0) + bk) * ldb + n0 + bn) : make_float4(0.f, 0.f, 0.f, 0.f); \
        if (DUAL) rb2 = bvalid ? *(const float4*)(B2 + (size_t)((k0) + bk) * ldb + n0 + bn) : make_float4(0.f, 0.f, 0.f, 0.f); } while (0)
    SG_LOAD(0);
    for (int k0 = 0; k0 < K; k0 += 16) {
        As[(ak + 0) * 132 + ar] = ra.x; As[(ak + 1) * 132 + ar] = ra.y; As[(ak + 2) * 132 + ar] = ra.z; As[(ak + 3) * 132 + ar] = ra.w;
        *(LAS f32x4*)(Bs + bk * 128 + bn) = (f32x4){rb.x, rb.y, rb.z, rb.w};
        if (DUAL) *(LAS f32x4*)(B2s + bk * 128 + bn) = (f32x4){rb2.x, rb2.y, rb2.z, rb2.w};
        __syncthreads();
        if (k0 + 16 < K) SG_LOAD(k0 + 16);
#pragma unroll 2
        for (int k = 0; k < 16; ++k) {
            const f32x4 a = *(const LAS f32x4*)(As + k * 132 + ty * 4);
            const f32x4 b0 = *(const LAS f32x4*)(Bs + k * 128 + tx * 8), b1 = *(const LAS f32x4*)(Bs + k * 128 + tx * 8 + 4);
            const float av[4] = {a.x, a.y, a.z, a.w}; const float bv[8] = {b0.x, b0.y, b0.z, b0.w, b1.x, b1.y, b1.z, b1.w};
#pragma unroll
            for (int i = 0; i < 4; ++i)
#pragma unroll
                for (int j = 0; j < 8; ++j) acc[i][j] = fmaf(av[i], bv[j], acc[i][j]);
            if (DUAL) {
                const f32x4 c0 = *(const LAS f32x4*)(B2s + k * 128 + tx * 8), c1 = *(const LAS f32x4*)(B2s + k * 128 + tx * 8 + 4);
                const float cv[8] = {c0.x, c0.y, c0.z, c0.w, c1.x, c1.y, c1.z, c1.w};
#pragma unroll
                for (int i = 0; i < 4; ++i)
#pragma unroll
                    for (int j = 0; j < 8; ++j) acc2[i][j] = fmaf(av[i], cv[j], acc2[i][j]);
            }
        }
        __syncthreads();
    }
#undef SG_LOAD
#pragma unroll
    for (int i = 0; i < 4; ++i) epi(ty * 4 + i, tx * 8, acc[i], acc2[i]);
}

__device__ __forceinline__ void store8_bf16(bf16_t* p, const float (&v)[8]) {
    uint4 o; o.x = pk2(v[0], v[1]); o.y = pk2(v[2], v[3]); o.z = pk2(v[4], v[5]); o.w = pk2(v[6], v[7]);
    *(uint4*)p = o;
}


namespace g8 {
typedef short bf16x8 __attribute__((ext_vector_type(8)));
typedef unsigned u32x4 __attribute__((ext_vector_type(4)));
typedef unsigned u32x2 __attribute__((ext_vector_type(2)));
constexpr int BM = 256, BK = 64, HALF = 128, HTB = HALF * BK * 2, STAGE_BYTES = 8 * HTB, NXCD = 8, WGM = 8;
__device__ __forceinline__ int lds_byte(int r, int c) { const int st = (r >> 4) * 2 + (c >> 5), rr = r & 15, cc = c & 31, ob = rr * 64 + cc * 2; return st * 1024 + (ob ^ (((ob >> 9) & 1) << 5)); }
__device__ __forceinline__ void stage_rc(int b, int& R, int& C) { const int st = b / 1024, sb = b % 1024, swz = sb ^ (((sb >> 9) & 1) << 5); R = (st >> 1) * 16 + swz / 64; C = (st & 1) * 32 + (swz % 64) / 2; }
__device__ __forceinline__ int perm32(int rho) { const int n = rho >> 4, i = rho & 15; return 8 * (i >> 2) + 4 * n + (i & 3); }
__device__ __forceinline__ unsigned cvt_pk_bf16(float lo, float hi) { unsigned r; asm volatile("v_cvt_pk_bf16_f32 %0, %1, %2" : "=v"(r) : "v"(lo), "v"(hi)); return r; }

struct Unit { unsigned ao, bo; int lidx, m0, n0, nvalid, kind; };

__device__ __forceinline__ int xcd_remap(int L, int nwg) { const int q = nwg / NXCD, r = nwg % NXCD, xcd = L % NXCD, off = L / NXCD; return (xcd < r ? xcd * (q + 1) : r * (q + 1) + (xcd - r) * q) + off; }
__device__ __forceinline__ void order_decode(int wgid, int nM, int nN, int& pm, int& pn) {
    const int nig = WGM * nN, gid = wgid / nig, fm = gid * WGM, gsz = (nM - fm) < WGM ? (nM - fm) : WGM;
    pm = fm + ((wgid % nig) % gsz); pn = (wgid % nig) / gsz;
}
struct DenseSched {
    static constexpr bool GATHER = false; const char* Abase; const char* Bbase; const int* list; int nM, nN, K, G, c;
    __device__ __forceinline__ bool next(int i, Unit& u) const {
        const int nwg = nM * nN; const int L = i * G + c; if (L >= nwg) return false;
        int pm, pn; order_decode(xcd_remap(L, nwg), nM, nN, pm, pn);
        u.ao = (unsigned)pm * 256u * (unsigned)K * 2u; u.bo = (unsigned)pn * 256u * (unsigned)K * 2u; u.lidx = -1; u.m0 = pm * 256; u.n0 = pn * 256; u.nvalid = 256; u.kind = 0; return true;
    }
};
struct MoeSched {
    static constexpr bool GATHER = true; int vt, vr, vcn; int NTR, nN1; const char* Abase; const char* Bbase; unsigned b1off, bstride; const int* list;
    int nM2, nN2; unsigned b2off; int K, G, c;
    __device__ __forceinline__ bool next(int i, Unit& u) const {
        const int NT1 = NTR + T / 256, U1 = NT1 * nN1, U2 = nM2 * nN2; const int L = i * G + c;
        const int x = L % NXCD, off = L / NXCD, q1 = U1 / NXCD, r1 = U1 % NXCD, q2 = U2 / NXCD, r2 = U2 % NXCD;
        const int n1 = q1 + (x < r1 ? 1 : 0), n2 = q2 + (x < r2 ? 1 : 0); if (off >= n1 + n2) return false;
        const bool blk1 = off < n1;
        const int w = blk1 ? x * q1 + (x < r1 ? x : r1) + off : x * q2 + (x < r2 ? x : r2) + (off - n1);
        int pm, pn; order_decode(w, blk1 ? NT1 : nM2, blk1 ? nN1 : nN2, pm, pn);
        pm = __builtin_amdgcn_readfirstlane(pm); pn = __builtin_amdgcn_readfirstlane(pn);
        const bool routed = blk1 && pm < NTR;
        const int pmr = routed ? pm : 0;
        const int e = __builtin_popcountll(__ballot(vt <= pmr)) - 1; const int te = __builtin_amdgcn_readlane(vt, e), ce = __builtin_amdgcn_readlane(vcn, e), re = __builtin_amdgcn_readlane(vr, e);
        const int ti = routed ? pm - te : (blk1 ? pm - NTR : pm);
        const int nv = ce - ti * 256;
        const int m0 = routed ? re + ti * 256 : (blk1 ? T * TOPK + ti * 256 : ti * 256);
        const bool gather = routed && list != nullptr;
        const unsigned arow = gather ? 0u : ((blk1 && list == nullptr) ? (unsigned)m0 : (unsigned)ti * 256u);
        u.ao = arow * (unsigned)K * 2u; u.bo = (blk1 ? b1off + (unsigned)(routed ? e : 64) * bstride : b2off) + (unsigned)pn * 256u * (unsigned)K * 2u;
        u.lidx = gather ? e * T + ti * 256 : -1; u.m0 = m0; u.n0 = pn * 256; u.nvalid = routed ? (nv < 256 ? nv : 256) : 256; u.kind = routed ? 1 : (blk1 ? 2 : 3);
        return true;
    }
};

typedef int i32x8 __attribute__((ext_vector_type(8)));
typedef int i32x4 __attribute__((ext_vector_type(4)));
__device__ __forceinline__ i32x8 cat8(bf16x8 a, bf16x8 b) { const i32x4 x = __builtin_bit_cast(i32x4, a), y = __builtin_bit_cast(i32x4, b); return __builtin_shufflevector(x, y, 0, 1, 2, 3, 4, 5, 6, 7); }
template <class Epi, class Sched, bool F8 = false>
__device__ __forceinline__ void gemm_phase(const int tid, LAS unsigned char* lds, const int K, const Sched& S, const Epi& E) {
    const int wid = __builtin_amdgcn_readfirstlane(tid >> 6), lane = tid & 63, wr = wid >> 2, wc = wid & 3, fr = lane & 15, fq = lane >> 4;
    const int nt = K / BK;
    unsigned voffB[2];
#pragma unroll
    for (int i = 0; i < 2; ++i) { int R, C; stage_rc(tid * 16 + i * 8192, R, C);
        const int Rb = Epi::PERM2 ? 64 * (R >> 5) + 16 * ((R >> 2) & 3) + 4 * ((R >> 4) & 1) + (R & 3) : (R & ~31) + perm32(R & 31); voffB[i] = (unsigned)(Rb * K + C) * 2u; }
    const unsigned kstep = (unsigned)(BK * 2);
    const unsigned hstep = (Epi::PERM2 ? 8u : (unsigned)HALF) * (unsigned)K * 2u;
    const unsigned ldsw = (unsigned)wid * 1024u;
    const int aoff = lds_byte(wr * 64 + fr, fq * 8), boff = lds_byte(wc * 32 + fr, fq * 8);
    const char* const Ab = S.Abase; const char* const Bb = S.Bbase;
#define G8_SA(b, h) (((b) * 2 + (h)) * HTB)
#define G8_SB(b, h) ((4 + (b) * 2 + (h)) * HTB)
#define G8_STAGE(bufoff, gbase, soff, voff) do { _Pragma("unroll") for (int _i = 0; _i < 2; ++_i) \
        __builtin_amdgcn_global_load_lds((const unsigned*)((gbase) + (size_t)(soff) + (voff)[_i]), (LAS unsigned*)(lds + (bufoff) + ldsw + _i * 8192), 16, 0, 0); } while (0)
#define G8_LDA(dst, b, h) do { _Pragma("unroll") for (int m = 0; m < 4; ++m) _Pragma("unroll") for (int k = 0; k < 2; ++k) dst[m][k] = *(const LAS bf16x8*)(lds + G8_SA(b, h) + aoff + m * 2048 + k * 1024); } while (0)
#define G8_LDB(dst, b, h) do { _Pragma("unroll") for (int n = 0; n < 2; ++n) _Pragma("unroll") for (int k = 0; k < 2; ++k) dst[n][k] = *(const LAS bf16x8*)(lds + G8_SB(b, h) + boff + n * 2048 + k * 1024); } while (0)
#define G8_MMA(ai, bj, At, Bt) do { __builtin_amdgcn_s_setprio(1); _Pragma("unroll") for (int m = 0; m < 4; ++m) _Pragma("unroll") for (int n = 0; n < 2; ++n) { \
        if constexpr (F8) acc[ai][bj][m][n] = __builtin_amdgcn_mfma_scale_f32_16x16x128_f8f6f4(cat8(Bt[n][0], Bt[n][1]), cat8(At[m][0], At[m][1]), acc[ai][bj][m][n], 0, 0, 0, Epi::SC8, 0, Epi::SC8); \
        else { _Pragma("unroll") for (int k = 0; k < 2; ++k) acc[ai][bj][m][n] = __builtin_amdgcn_mfma_f32_16x16x32_bf16(Bt[n][k], At[m][k], acc[ai][bj][m][n], 0, 0, 0); } } \
        __builtin_amdgcn_s_setprio(0); } while (0)
#define G8_WAIT_V(n) asm volatile("s_waitcnt vmcnt(" #n ")" ::: "memory")
#define G8_WAIT_L(n) asm volatile("s_waitcnt lgkmcnt(" #n ")" ::: "memory")
#define G8_BAR __builtin_amdgcn_s_barrier()
#define G8_SCHED __builtin_amdgcn_sched_barrier(0)
#define G8_LOADV(dst, u) do { int R0_, C0_, R1_, C1_; stage_rc(tid * 16, R0_, C0_); stage_rc(tid * 16 + 8192, R1_, C1_); \
        if ((u).lidx >= 0) { const int* lp_ = S.list + (u).lidx; const int nv_ = (u).nvalid - 1; \
            const int i00 = lp_[R0_ < nv_ ? R0_ : nv_], i01 = lp_[R1_ < nv_ ? R1_ : nv_], i10 = lp_[R0_ + 128 < nv_ ? R0_ + 128 : nv_], i11 = lp_[R1_ + 128 < nv_ ? R1_ + 128 : nv_]; \
            dst[0][0] = ((unsigned)i00 * (unsigned)K + (unsigned)C0_) * 2u; dst[0][1] = ((unsigned)i01 * (unsigned)K + (unsigned)C1_) * 2u; \
            dst[1][0] = ((unsigned)i10 * (unsigned)K + (unsigned)C0_) * 2u; dst[1][1] = ((unsigned)i11 * (unsigned)K + (unsigned)C1_) * 2u; } \
        else { dst[0][0] = ((unsigned)R0_ * (unsigned)K + (unsigned)C0_) * 2u; dst[0][1] = ((unsigned)R1_ * (unsigned)K + (unsigned)C1_) * 2u; \
            dst[1][0] = ((unsigned)(R0_ + 128) * (unsigned)K + (unsigned)C0_) * 2u; dst[1][1] = ((unsigned)(R1_ + 128) * (unsigned)K + (unsigned)C1_) * 2u; } } while (0)
    Unit cur, nxt; int ui = 0;
    if (!S.next(0, cur)) return;
    f32x4 acc[2][2][4][2];
#pragma unroll
    for (int a = 0; a < 2; ++a)
#pragma unroll
        for (int b = 0; b < 2; ++b)
#pragma unroll
            for (int m = 0; m < 4; ++m)
#pragma unroll
                for (int n = 0; n < 2; ++n) acc[a][b][m][n] = (f32x4){0.f, 0.f, 0.f, 0.f};
    bf16x8 At[4][2], B0[2][2], B1[2][2];
    unsigned vc[2][2], vn[2][2];
    G8_LOADV(vc, cur);
    unsigned cA = cur.ao, cB = cur.bo;
    G8_STAGE(G8_SB(0, 0), Bb, cB, voffB); G8_STAGE(G8_SB(0, 1), Bb, cB + hstep, voffB); G8_STAGE(G8_SA(0, 0), Ab, cA, vc[0]); G8_STAGE(G8_SA(0, 1), Ab, cA, vc[1]);
    if (wr == 1) G8_BAR;
    G8_WAIT_V(2); G8_BAR;
    G8_STAGE(G8_SB(1, 0), Bb, cB + kstep, voffB); G8_STAGE(G8_SA(1, 0), Ab, cA + kstep, vc[0]); G8_STAGE(G8_SB(1, 1), Bb, cB + hstep + kstep, voffB);
    G8_WAIT_V(6); G8_BAR;
    for (;;) {
        const bool has_next = S.next(ui + 1, nxt);
        const unsigned nA = has_next ? nxt.ao : cA, nB = has_next ? nxt.bo : cB;
        if constexpr (Sched::GATHER) { if (has_next) { G8_LOADV(vn, nxt); } else {
#pragma unroll
            for (int h = 0; h < 2; ++h)
#pragma unroll
                for (int i = 0; i < 2; ++i) vn[h][i] = vc[h][i]; } }
#pragma unroll 1
        for (int t = 0; t < nt; t += 2) {
            const bool last = (t == nt - 2);
            unsigned tk = (unsigned)t * kstep; asm volatile("" : "+s"(tk));
            const unsigned a1 = cA + tk + kstep;
            const unsigned a2 = last ? nA : cA + tk + 2 * kstep, b2 = last ? nB : cB + tk + 2 * kstep;
            const unsigned a3 = a2 + kstep, b3 = b2 + kstep;
            if constexpr (Epi::MIDK) { if (t == nt / 2) E.midk(acc, cur, wr, wc, fr, fq); }
            G8_LDB(B0, 0, 0); G8_LDB(B1, 0, 1); G8_SCHED; G8_LDA(At, 0, 0); G8_STAGE(G8_SA(1, 1), Ab, a1, vc[1]);
            if constexpr (Sched::GATHER) { if (last) { _Pragma("unroll") for (int h = 0; h < 2; ++h) _Pragma("unroll") for (int i = 0; i < 2; ++i) vc[h][i] = vn[h][i]; } }
            G8_WAIT_V(8); G8_WAIT_L(0); G8_BAR; G8_MMA(0, 0, At, B0); G8_MMA(0, 1, At, B1); G8_BAR; G8_SCHED;
            G8_LDA(At, 0, 1); G8_STAGE(G8_SB(0, 0), Bb, b2, voffB); G8_STAGE(G8_SB(0, 1), Bb, b2 + hstep, voffB); G8_STAGE(G8_SA(0, 0), Ab, a2, vc[0]);
            G8_WAIT_V(8); G8_WAIT_L(0); G8_BAR; G8_MMA(1, 0, At, B0); G8_MMA(1, 1, At, B1); G8_BAR; G8_SCHED;
            G8_LDB(B0, 1, 0); G8_LDB(B1, 1, 1); G8_SCHED; G8_LDA(At, 1, 0); G8_STAGE(G8_SA(0, 1), Ab, a2, vc[1]);
            G8_WAIT_V(8); G8_WAIT_L(0); G8_BAR; G8_MMA(0, 0, At, B0); G8_MMA(0, 1, At, B1); G8_BAR; G8_SCHED;
            G8_LDA(At, 1, 1); G8_STAGE(G8_SB(1, 0), Bb, b3, voffB); G8_STAGE(G8_SB(1, 1), Bb, b3 + hstep, voffB); G8_STAGE(G8_SA(1, 0), Ab, a3, vc[0]);
            G8_WAIT_V(8); G8_WAIT_L(0); G8_BAR; G8_MMA(1, 0, At, B0); G8_MMA(1, 1, At, B1); G8_BAR; G8_SCHED;
        }
        if (wr == 0) G8_BAR;
        E(acc, cur, wr, wc, fr, fq);
        if (!has_next) break;
#pragma unroll
        for (int a = 0; a < 2; ++a)
#pragma unroll
            for (int b = 0; b < 2; ++b)
#pragma unroll
                for (int m = 0; m < 4; ++m)
#pragma unroll
                    for (int n = 0; n < 2; ++n) acc[a][b][m][n] = (f32x4){0.f, 0.f, 0.f, 0.f};
        cur = nxt; cA = nA; cB = nB; ++ui;
        if (wr == 1) G8_BAR;
    }
    G8_WAIT_V(0);
    G8_BAR;
#undef G8_SA
#undef G8_SB
#undef G8_STAGE
#undef G8_LDA
#undef G8_LDB
#undef G8_MMA
#undef G8_WAIT_V
#undef G8_WAIT_L
#undef G8_BAR
#undef G8_SCHED
#undef G8_LOADV
}

__device__ __forceinline__ float fast_sigmoid(float x) { return __builtin_amdgcn_rcpf(1.0f + __expf(-x)); }
__device__ __forceinline__ float gelu_tanh_fast(float x) { return x * fast_sigmoid(1.5957691216057308f * (x + 0.044715f * x * x * x)); }

struct EpiZ {
    static constexpr int SC8 = 0x7C7C7C7C; static constexpr bool MIDK = false, PERM2 = false; bf16_t* Zp; int coff; unsigned* nrm;
    __device__ __forceinline__ void operator()(const f32x4 (&acc)[2][2][4][2], const Unit& u, int wr, int wc, int fr, int fq) const {
        const int c0 = coff + u.n0; const bool act = (c0 >= OFF_GMLP && c0 < OFF_Q);
#pragma unroll
        for (int ai = 0; ai < 2; ++ai)
#pragma unroll
            for (int m = 0; m < 4; ++m) { bf16_t* rowp = Zp + (size_t)(u.m0 + ai * HALF + wr * 64 + m * 16 + fr) * ZW + c0 + wc * 32 + 8 * fq;
#pragma unroll
                for (int bj = 0; bj < 2; ++bj) { f32x4 v0 = acc[ai][bj][m][0], v1 = acc[ai][bj][m][1];
                    if (act) {
#pragma unroll
                        for (int j = 0; j < 4; ++j) { v0[j] = gelu_tanh_fast(v0[j]); v1[j] = gelu_tanh_fast(v1[j]); } }
                    u32x4 w; w.x = cvt_pk_bf16(v0[0], v0[1]); w.y = cvt_pk_bf16(v0[2], v0[3]); w.z = cvt_pk_bf16(v1[0], v1[1]); w.w = cvt_pk_bf16(v1[2], v1[3]);
                    *(u32x4*)(rowp + bj * HALF) = w; } }
        if (nrm != nullptr && c0 >= OFF_Q && c0 < OFF_V) {
            float mx0 = 0.f, mx1 = 0.f;
#pragma unroll
            for (int ai = 0; ai < 2; ++ai)
#pragma unroll
                for (int m = 0; m < 4; ++m)
#pragma unroll
                    for (int bj = 0; bj < 2; ++bj) { const f32x4 v0 = acc[ai][bj][m][0], v1 = acc[ai][bj][m][1];
                        float ss = (v0[0] * v0[0] + v0[1] * v0[1]) + (v0[2] * v0[2] + v0[3] * v0[3]) + (v1[0] * v1[0] + v1[1] * v1[1]) + (v1[2] * v1[2] + v1[3] * v1[3]);
                        ss += swz_xor<16>(ss); { const auto rr = __builtin_amdgcn_permlane32_swap(__float_as_uint(ss), __float_as_uint(ss), false, false); ss = __uint_as_float(rr[0]) + __uint_as_float(rr[1]); }
                        if (bj == 0) mx0 = fmaxf(mx0, ss); else mx1 = fmaxf(mx1, ss); }
            mx0 = fmaxf(mx0, swz_xor<1>(mx0)); mx0 = fmaxf(mx0, swz_xor<2>(mx0)); mx0 = fmaxf(mx0, swz_xor<4>(mx0)); mx0 = fmaxf(mx0, swz_xor<8>(mx0));
            mx1 = fmaxf(mx1, swz_xor<1>(mx1)); mx1 = fmaxf(mx1, swz_xor<2>(mx1)); mx1 = fmaxf(mx1, swz_xor<4>(mx1)); mx1 = fmaxf(mx1, swz_xor<8>(mx1));
            if (fr == 0 && fq == 0) { const int sel = c0 >= OFF_K ? 1 : 0, bb = u.m0 / S, h0 = (c0 & 1023) >> 7; unsigned* np = nrm + ((sel * 64 + bb * 8 + h0) * 4 + wc);
                atomicMax(np, __float_as_uint(mx0)); atomicMax(np + 4, __float_as_uint(mx1)); }
        }
    }
};
struct EpiBf {
    static constexpr bool MIDK = false, PERM2 = false; bf16_t* O; int ldc;
    __device__ __forceinline__ void operator()(const f32x4 (&acc)[2][2][4][2], const Unit& u, int wr, int wc, int fr, int fq) const {
#pragma unroll
        for (int ai = 0; ai < 2; ++ai)
#pragma unroll
            for (int m = 0; m < 4; ++m) { bf16_t* rowp = O + (size_t)(u.m0 + ai * HALF + wr * 64 + m * 16 + fr) * ldc + u.n0 + wc * 32 + 8 * fq;
#pragma unroll
                for (int bj = 0; bj < 2; ++bj) { const f32x4 v0 = acc[ai][bj][m][0], v1 = acc[ai][bj][m][1];
                    u32x4 w; w.x = cvt_pk_bf16(v0[0], v0[1]); w.y = cvt_pk_bf16(v0[2], v0[3]); w.z = cvt_pk_bf16(v1[0], v1[1]); w.w = cvt_pk_bf16(v1[2], v1[3]);
                    *(u32x4*)(rowp + bj * HALF) = w; } }
    }
};
struct EpiU1 {
    static constexpr bool MIDK = true, PERM2 = false; const bf16_t* X; float* U; const float* ssq;
    __device__ __forceinline__ void midk(f32x4 (&acc)[2][2][4][2], const Unit& u, int wr, int wc, int fr, int fq) const {
#pragma unroll
        for (int ai = 0; ai < 2; ++ai)
#pragma unroll
            for (int m = 0; m < 4; ++m) { const float* sp = ssq + (size_t)(u.m0 + ai * HALF + wr * 64 + m * 16 + fr) * 8; const f32x4 s0 = *(const f32x4*)sp, s1 = *(const f32x4*)(sp + 4);
                const float rc = rsqrtf(((s0[0] + s0[1]) + (s0[2] + s0[3]) + (s1[0] + s1[1]) + (s1[2] + s1[3])) * (1.f / 1024.f) + LN_EPS);
#pragma unroll
                for (int bj = 0; bj < 2; ++bj)
#pragma unroll
                    for (int n = 0; n < 2; ++n) acc[ai][bj][m][n] *= rc;
                if (m & 1) asm volatile("" ::: "memory"); }
    }
    __device__ __forceinline__ void operator()(const f32x4 (&acc)[2][2][4][2], const Unit& u, int wr, int wc, int fr, int fq) const {
        u32x4 xs[2][4][2];
#pragma unroll
        for (int ai = 0; ai < 2; ++ai)
#pragma unroll
            for (int m = 0; m < 4; ++m) { const size_t o = (size_t)(u.m0 + ai * HALF + wr * 64 + m * 16 + fr) * D + u.n0 + wc * 32 + 8 * fq;
#pragma unroll
                for (int bj = 0; bj < 2; ++bj) xs[ai][m][bj] = *(const u32x4*)(X + o + bj * HALF); }
        asm volatile("" ::: "memory");
#pragma unroll
        for (int ai = 0; ai < 2; ++ai)
#pragma unroll
            for (int m = 0; m < 4; ++m) { const size_t o = (size_t)(u.m0 + ai * HALF + wr * 64 + m * 16 + fr) * D + u.n0 + wc * 32 + 8 * fq;
#pragma unroll
                for (int bj = 0; bj < 2; ++bj) { const u32x4 xv = xs[ai][m][bj]; const f32x4 v0 = acc[ai][bj][m][0], v1 = acc[ai][bj][m][1];
                    f32x4 o0, o1; o0[0] = fmaf(ALPHA, bflo(xv.x), v0[0]); o0[1] = fmaf(ALPHA, bfhi(xv.x), v0[1]); o0[2] = fmaf(ALPHA, bflo(xv.y), v0[2]); o0[3] = fmaf(ALPHA, bfhi(xv.y), v0[3]);
                    o1[0] = fmaf(ALPHA, bflo(xv.z), v1[0]); o1[1] = fmaf(ALPHA, bfhi(xv.z), v1[1]); o1[2] = fmaf(ALPHA, bflo(xv.w), v1[2]); o1[3] = fmaf(ALPHA, bfhi(xv.w), v1[3]);
                    u32x4 w; w.x = cvt_pk_bf16(o0[0], o0[1]); w.y = cvt_pk_bf16(o0[2], o0[3]); w.z = cvt_pk_bf16(o1[0], o1[1]); w.w = cvt_pk_bf16(o1[2], o1[3]);
                    *(u32x4*)((bf16_t*)U + o + bj * HALF) = w; } }
    }
};
struct EpiUp {
    static constexpr int SC8 = USE_FP8 ? 0x7C7C7C7C : 0x7F7F7F7F;     static constexpr bool MIDK = false, PERM2 = false; void* Hp; const bf16_t* X; const bf16_t* PEp; const float* bpg; bf16_t* B16; float osc; bool h8;
    __device__ __forceinline__ void operator()(const f32x4 (&acc)[2][2][4][2], const Unit& u, int wr, int wc, int fr, int fq) const {
        if (u.kind != 3) {
#pragma unroll
            for (int ai = 0; ai < 2; ++ai)
#pragma unroll
                for (int m = 0; m < 4; ++m) { const int rl = ai * HALF + wr * 64 + m * 16 + fr;
                    if (rl < u.nvalid) { const size_t eo = (size_t)(u.m0 + rl) * DE + (u.n0 >> 1) + wc * 16 + 4 * fq;
#pragma unroll
                        for (int bj = 0; bj < 2; ++bj) { f32x4 a = acc[ai][bj][m][0], b = acc[ai][bj][m][1]; if (!USE_FP8) { a *= osc; b *= osc; } float hv[4];
#pragma unroll
                            for (int j = 0; j < 4; ++j) hv[j] = a[j] * fast_sigmoid(a[j]) * b[j];
                            if (h8) *(unsigned*)((unsigned char*)Hp + eo + bj * 64) = pk4_fp8(hv[0], hv[1], hv[2], hv[3]);
                            else { u32x2 w; w.x = cvt_pk_bf16(hv[0], hv[1]); w.y = cvt_pk_bf16(hv[2], hv[3]); *(u32x2*)((bf16_t*)Hp + eo + bj * 64) = w; } } } }
        } else {
            f32x4 gb[2][2];
#pragma unroll
            for (int bj = 0; bj < 2; ++bj) { gb[bj][0] = *(const f32x4*)(bpg + u.n0 + wc * 32 + 8 * fq + bj * HALF); gb[bj][1] = *(const f32x4*)(bpg + u.n0 + wc * 32 + 8 * fq + bj * HALF + 4); }
#pragma unroll
            for (int ai = 0; ai < 2; ++ai) {
                u32x4 xs[4][2], ps[4][2];
#pragma unroll
                for (int m = 0; m < 4; ++m) { const size_t o = (size_t)(u.m0 + ai * HALF + wr * 64 + m * 16 + fr) * D + u.n0 + wc * 32 + 8 * fq;
#pragma unroll
                    for (int bj = 0; bj < 2; ++bj) { xs[m][bj] = *(const u32x4*)(X + o + bj * HALF); ps[m][bj] = *(const u32x4*)(PEp + o + bj * HALF); } }
                asm volatile("" ::: "memory");
#pragma unroll
                for (int m = 0; m < 4; ++m) { const size_t o = (size_t)(u.m0 + ai * HALF + wr * 64 + m * 16 + fr) * D + u.n0 + wc * 32 + 8 * fq;
#pragma unroll
                    for (int bj = 0; bj < 2; ++bj) { const u32x4 xv = xs[m][bj], pv = ps[m][bj];
                        const f32x4 v0 = (USE_FP8 ? acc[ai][bj][m][0] : acc[ai][bj][m][0] * osc) + gb[bj][0], v1 = (USE_FP8 ? acc[ai][bj][m][1] : acc[ai][bj][m][1] * osc) + gb[bj][1]; f32x4 o0, o1;
                        o0[0] = fmaf(ALPHA, bflo(xv.x), fast_sigmoid(v0[0]) * bflo(pv.x)); o0[1] = fmaf(ALPHA, bfhi(xv.x), fast_sigmoid(v0[1]) * bfhi(pv.x));
                        o0[2] = fmaf(ALPHA, bflo(xv.y), fast_sigmoid(v0[2]) * bflo(pv.y)); o0[3] = fmaf(ALPHA, bfhi(xv.y), fast_sigmoid(v0[3]) * bfhi(pv.y));
                        o1[0] = fmaf(ALPHA, bflo(xv.z), fast_sigmoid(v1[0]) * bflo(pv.z)); o1[1] = fmaf(ALPHA, bfhi(xv.z), fast_sigmoid(v1[1]) * bfhi(pv.z));
                        o1[2] = fmaf(ALPHA, bflo(xv.w), fast_sigmoid(v1[2]) * bflo(pv.w)); o1[3] = fmaf(ALPHA, bfhi(xv.w), fast_sigmoid(v1[3]) * bfhi(pv.w));
                        u32x4 w; w.x = cvt_pk_bf16(o0[0], o0[1]); w.y = cvt_pk_bf16(o0[2], o0[3]); w.z = cvt_pk_bf16(o1[0], o1[1]); w.w = cvt_pk_bf16(o1[2], o1[3]);
                        *(u32x4*)(B16 + o + bj * HALF) = w; } }
                asm volatile("" ::: "memory"); }
        }
    }
};
struct EpiDown {
    static constexpr int SC8 = USE_FP8 ? 0x7E7E7E7E : 0x7F7F7F7F;     static constexpr bool MIDK = false, PERM2 = true; unsigned char* Y2p; unsigned char* YSp; float osc;
    __device__ __forceinline__ void operator()(const f32x4 (&acc)[2][2][4][2], const Unit& u, int wr, int wc, int fr, int fq) const {
        const float sc = osc * Y2_SCALE;
        unsigned char* const base = u.kind == 1 ? Y2p + (size_t)u.m0 * D : YSp + (size_t)(u.m0 - T * TOPK) * (2 * D);
        const unsigned rstride = u.kind == 1 ? (unsigned)D : (unsigned)(2 * D);
        const unsigned off0 = (unsigned)(wr * 64 + fr) * rstride + (unsigned)(u.n0 + wc * 64 + 16 * fq);
#pragma unroll
        for (int ai = 0; ai < 2; ++ai)
#pragma unroll
            for (int m = 0; m < 4; ++m) { const int rl = ai * HALF + wr * 64 + m * 16 + fr;
                if (rl < u.nvalid) {
                    f32x4 a0 = acc[ai][0][m][0], a1 = acc[ai][0][m][1], b0 = acc[ai][1][m][0], b1 = acc[ai][1][m][1];
                    if (!USE_FP8) { a0 *= sc; a1 *= sc; b0 *= sc; b1 *= sc; }
                    u32x4 w; w.x = pk4_fp8(a0[0], a0[1], a0[2], a0[3]); w.y = pk4_fp8(a1[0], a1[1], a1[2], a1[3]); w.z = pk4_fp8(b0[0], b0[1], b0[2], b0[3]); w.w = pk4_fp8(b1[0], b1[1], b1[2], b1[3]);
                    *(u32x4*)(base + (off0 + (unsigned)(ai * HALF + m * 16) * rstride)) = w; } }
    }
};
}


namespace att {
typedef short bf16x8 __attribute__((ext_vector_type(8)));
typedef short s16x4 __attribute__((ext_vector_type(4)));
typedef float f32x16 __attribute__((ext_vector_type(16)));
typedef unsigned u32x4 __attribute__((ext_vector_type(4)));
constexpr int DH = 128, NW = 8, QBLK = 32, KVBLK = 64, QB = NW * QBLK, NQB = S / QB;
constexpr int SHM_V = KVBLK * DH * 2, SHM_K = KVBLK * DH * 2;
constexpr int LDS_ATT = 2 * SHM_V + 2 * SHM_K + NW * 64 * 4;
constexpr int LDS_C = LDS_ATT;
constexpr float SCALE = 0.08838834764831845f, THR = 8.f, INV_SCALE = 11.313708498984761f;
constexpr int QKV_LD = ZW, O_LD = D;
#define KSWZ(row, colB) ((row) * 256 + ((colB) ^ (((row) & 7) << 4)))
#define SBAR() __builtin_amdgcn_sched_barrier(0)
__device__ __forceinline__ int v_st(int k, int c) { const int kk = (k & ~0xC) | ((k & 4) << 1) | ((k & 8) >> 1); return ((kk >> 3) * 4 + (c >> 5)) * 512 + ((kk & 7) * 32 + (c & 31)) * 2; }
__device__ __forceinline__ int v_rd_base(int lane) { return ((lane & 3) << 3) | (((lane >> 2) & 3) << 6) | (((lane >> 4) & 1) << 5) | (((lane >> 5) & 1) << 8); }
constexpr int v_rd_off(int d0, int ks, int half) { return d0 * 512 + ks * 4096 + half * 2048; }
__device__ __forceinline__ int crow(int r, int hi) { return (r & 3) + 8 * (r >> 2) + 4 * hi; }
__device__ __forceinline__ unsigned cvtpk(float lo, float hi) { unsigned r; asm volatile("v_cvt_pk_bf16_f32 %0, %1, %2" : "=v"(r) : "v"(lo), "v"(hi)); return r; }
__device__ __forceinline__ bf16x8 load8(const bf16_t* p) { return *reinterpret_cast<const bf16x8*>(p); }
__device__ __forceinline__ void mask_tile(f32x16& p0, f32x16& p1, int dq) {
    const float NEG = -__builtin_inff();
#pragma unroll
    for (int r = 0; r < 16; ++r) {
        const int c = (r & 3) + 8 * (r >> 2);
        if (dq - c < 0) p0[r] = NEG;
        if (dq - c - 32 < 0) p1[r] = NEG;
    }
}
__device__ __forceinline__ void partialSM(f32x16& p0, f32x16& p1, float& m_reg, float& mn, float& alpha) {
    float pmax = p0[0]; for (int r = 1; r < 16; ++r) pmax = fmaxf(pmax, p0[r]); for (int r = 0; r < 16; ++r) pmax = fmaxf(pmax, p1[r]);
    { auto rr = __builtin_amdgcn_permlane32_swap(__float_as_uint(pmax), __float_as_uint(pmax), false, false);
      pmax = fmaxf(__uint_as_float(rr[0]), __uint_as_float(rr[1])); }
    constexpr float C2 = 1.4426950408889634f * SCALE;
    if (__builtin_expect(__all((pmax - m_reg) * SCALE <= THR), 1)) { mn = m_reg; alpha = 1.f; }
    else { mn = fmaxf(m_reg, pmax); alpha = __builtin_amdgcn_exp2f((m_reg - mn) * C2); m_reg = mn; }
    const float mnL = -mn * C2;
    for (int r = 0; r < 16; ++r) p0[r] = fmaf(p0[r], C2, mnL); for (int r = 0; r < 16; ++r) p1[r] = fmaf(p1[r], C2, mnL);
    for (int r = 0; r < 16; ++r) p0[r] = __builtin_amdgcn_exp2f(p0[r]);
}
__device__ __forceinline__ void finishSM(f32x16& p0, f32x16& p1, float alpha, float& l_reg, bf16x8& pa0, bf16x8& pa1, bf16x8& pa2, bf16x8& pa3) {
    for (int r = 0; r < 16; ++r) p1[r] = __builtin_amdgcn_exp2f(p1[r]);
    float ps = 0; for (int r = 0; r < 16; ++r) ps += p0[r]; for (int r = 0; r < 16; ++r) ps += p1[r];
    { auto rr = __builtin_amdgcn_permlane32_swap(__float_as_uint(ps), __float_as_uint(ps), false, false);
      ps = __uint_as_float(rr[0]) + __uint_as_float(rr[1]); }
    l_reg = l_reg * alpha + ps;
#define PK4(P, B_, OUT) do { unsigned a0 = cvtpk(P[B_+0], P[B_+1]), a1 = cvtpk(P[B_+2], P[B_+3]);                          \
        unsigned b0 = cvtpk(P[B_+4], P[B_+5]), b1 = cvtpk(P[B_+6], P[B_+7]);                                             \
        auto r0 = __builtin_amdgcn_permlane32_swap(a0, b0, false, false); auto r1 = __builtin_amdgcn_permlane32_swap(a1, b1, false, false); \
        u32x4 w = {r0[0], r1[0], r0[1], r1[1]}; OUT = *reinterpret_cast<bf16x8*>(&w); } while (0)
    PK4(p0, 0, pa0); PK4(p0, 8, pa1); PK4(p1, 0, pa2); PK4(p1, 8, pa3);
#undef PK4
}
template <int KB>
__device__ __forceinline__ void qkt(f32x16& p0, f32x16& p1, const LAS char* K_lds, int r32, int hi, const bf16x8* qr, const LAS float* cl, int kb, float cref) {
    p0 = f32x16{}; p1 = f32x16{};
    const LAS char* kbp[4];
#pragma unroll
    for (int dd = 0; dd < 4; ++dd) kbp[dd] = K_lds + KB * SHM_K + KSWZ(r32, (dd * 16 + hi * 8) * 2);
#pragma unroll
    for (int d0 = 0; d0 < 8; ++d0) { const LAS char* a = kbp[d0 & 3] + (d0 >> 2) * 128;
        bf16x8 b0 = *reinterpret_cast<const LAS bf16x8*>(a);
        bf16x8 b1 = *reinterpret_cast<const LAS bf16x8*>(a + 32 * 256);
        p0 = __builtin_amdgcn_mfma_f32_32x32x16_bf16(b0, qr[d0], p0, 0, 0, 0);
        p1 = __builtin_amdgcn_mfma_f32_32x32x16_bf16(b1, qr[d0], p1, 0, 0, 0); }
    { const float x0 = (cref - cl[kb + r32]) * INV_SCALE, x1 = (cref - cl[kb + 32 + r32]) * INV_SCALE;
      const unsigned h0 = f2bf(x0), h1 = f2bf(x1); const unsigned l0 = f2bf(x0 - __uint_as_float(h0 << 16)), l1 = f2bf(x1 - __uint_as_float(h1 << 16));
      const u32x4 w0 = {hi == 0 ? (h0 | (l0 << 16)) : 0u, 0u, 0u, 0u}, w1 = {hi == 0 ? (h1 | (l1 << 16)) : 0u, 0u, 0u, 0u}, wq = {hi == 0 ? 0x3F803F80u : 0u, 0u, 0u, 0u};
      p0 = __builtin_amdgcn_mfma_f32_32x32x16_bf16(__builtin_bit_cast(bf16x8, w0), __builtin_bit_cast(bf16x8, wq), p0, 0, 0, 0);
      p1 = __builtin_amdgcn_mfma_f32_32x32x16_bf16(__builtin_bit_cast(bf16x8, w1), __builtin_bit_cast(bf16x8, wq), p1, 0, 0, 0); }
}
template <int VB>
__device__ __forceinline__ void pv_tile(f32x16* o, int vb0, bf16x8 pa0, bf16x8 pa1, bf16x8 pa2, bf16x8 pa3) {
#define TRRD(dst, off) asm volatile("ds_read_b64_tr_b16 %0, %1 offset:%2" : "=&v"(dst) : "v"(vb0), "i"(off) : "memory")
#define PV_D0(d0) do { s16x4 l0, l1, l2, l3, h0, h1, h2, h3; constexpr int b_ = VB * SHM_V + v_rd_off(d0, 0, 0); \
        TRRD(l0, b_); TRRD(h0, b_ + 2048); TRRD(l1, b_ + 4096); TRRD(h1, b_ + 6144); TRRD(l2, b_ + 8192); TRRD(h2, b_ + 10240); TRRD(l3, b_ + 12288); TRRD(h3, b_ + 14336); \
        asm volatile("s_waitcnt lgkmcnt(0)" ::: "memory"); SBAR(); \
        o[d0] = __builtin_amdgcn_mfma_f32_32x32x16_bf16(pa0, (bf16x8){l0[0], l0[1], l0[2], l0[3], h0[0], h0[1], h0[2], h0[3]}, o[d0], 0, 0, 0);   \
        o[d0] = __builtin_amdgcn_mfma_f32_32x32x16_bf16(pa1, (bf16x8){l1[0], l1[1], l1[2], l1[3], h1[0], h1[1], h1[2], h1[3]}, o[d0], 0, 0, 0);   \
        o[d0] = __builtin_amdgcn_mfma_f32_32x32x16_bf16(pa2, (bf16x8){l2[0], l2[1], l2[2], l2[3], h2[0], h2[1], h2[2], h2[3]}, o[d0], 0, 0, 0);   \
        o[d0] = __builtin_amdgcn_mfma_f32_32x32x16_bf16(pa3, (bf16x8){l3[0], l3[1], l3[2], l3[3], h3[0], h3[1], h3[2], h3[3]}, o[d0], 0, 0, 0); } while (0)
    PV_D0(0); PV_D0(1); PV_D0(2); PV_D0(3);
#undef PV_D0
#undef TRRD
}
struct BlockRef { unsigned qo, ko, vo, oo; int P0, hh, grow, t0; };
struct Seam { bf16x8 qr[8]; bf16x8 st_v0, st_v1, st_k0, st_k1; };
#define VMW() asm volatile("s_waitcnt vmcnt(0)" ::: "memory")
#define VMWN(n) asm volatile("s_waitcnt vmcnt(%0)" :: "i"(n) : "memory")
#define GLD8(base, soff, voff) (*(const bf16x8*)((base) + (size_t)(soff) + (voff)))
#define SLOAD_H(kofs, vofs, k0) do { const unsigned t_ = (unsigned)(k0) * (unsigned)(QKV_LD * 2); \
        S.st_v0 = GLD8(zb, (vofs) + t_, kv0); S.st_v1 = GLD8(zb, (vofs) + t_ + 32u * QKV_LD * 2u, kv0); S.st_k0 = GLD8(zb, (kofs) + t_, kv0); S.st_k1 = GLD8(zb, (kofs) + t_ + 32u * QKV_LD * 2u, kv0); } while (0)
#define SWRITE_HK(bf) do { *(LAS bf16x8*)(K_lds + (bf) * SHM_K + kws) = S.st_k0; *(LAS bf16x8*)(K_lds + (bf) * SHM_K + kws + 32 * 256) = S.st_k1; } while (0)
#define SWRITE_HV(bf) do { *(LAS bf16x8*)(V_lds + (bf) * SHM_V + vst0) = S.st_v0; *(LAS bf16x8*)(V_lds + (bf) * SHM_V + vst0 + 8192) = S.st_v1; } while (0)
#define SWRITE_H(bf) do { SWRITE_HV(bf); SWRITE_HK(bf); } while (0)
__device__ __forceinline__ void fox_prime(const int tid, const BlockRef& cur, const char* zb, LAS char* lds, Seam& S) {
    const int wid = __builtin_amdgcn_readfirstlane(tid >> 6), lane = tid & 63, r32 = lane & 31, hi = lane >> 5;
    const int sr = tid >> 4, sc = (tid & 15) * 8, kws = KSWZ(sr, sc * 2); LAS char* K_lds = lds + 2 * SHM_V;
    const unsigned kv0 = (unsigned)(sr * QKV_LD + sc) * 2u, qv = (unsigned)((wid * QBLK + r32) * QKV_LD + hi * 8) * 2u;
#pragma unroll
    for (int d0 = 0; d0 < 8; ++d0) S.qr[d0] = GLD8(zb, cur.qo, qv + d0 * 32);
    SLOAD_H(cur.ko, cur.vo, cur.t0 * KVBLK); VMW(); SWRITE_HK(0);
    __syncthreads();
}
__device__ __forceinline__ void fox_block(const int tid, const BlockRef& cur, const BlockRef& nxt, const char* zb, char* yb, const float* og, float* ssq, LAS char* lds, Seam& S) {
    const int wid = __builtin_amdgcn_readfirstlane(tid >> 6), lane = tid & 63, r32 = lane & 31, hi = lane >> 5;
    const int NT = (cur.P0 + QB - 1) / KVBLK + 1 - cur.t0;
    const int qlo = cur.P0 + wid * QBLK, qm = qlo + r32 - 4 * hi;
    LAS char* V_lds = lds; LAS char* K_lds = lds + 2 * SHM_V;
    LAS float* ws = (LAS float*)(lds + 2 * SHM_V + 2 * SHM_K) + wid * 64; LAS float* li_l = ws; LAS float* al_l = ws + 32;
    const LAS float* cl = (const LAS float*)(lds + LDS_C); const float cref = __int_as_float(__builtin_amdgcn_readfirstlane(__float_as_int(cl[cur.P0])));
    float m_reg = -1e30f, l_reg = 0; f32x16 o[4] = {};
    const int sr = tid >> 4, sc = (tid & 15) * 8, vst0 = v_st(sr, sc), kws = KSWZ(sr, sc * 2);
    const unsigned kv0 = (unsigned)(sr * QKV_LD + sc) * 2u;
    const int vb0 = (int)(unsigned)(size_t)V_lds + v_rd_base(lane);
#define RESC(a) do { if (__any((a) < 1.f)) { if (hi == 0) al_l[r32] = (a); asm volatile("s_waitcnt lgkmcnt(0)" ::: "memory");              \
                     for (int d_ = 0; d_ < 4; ++d_) for (int r = 0; r < 16; ++r) o[d_][r] *= al_l[crow(r, hi)]; } } while (0)
#define KBASE(t) (((t) + cur.t0) * KVBLK)
#define MASKT(P0_, P1_, t) do { const int kb_ = KBASE(t); if (kb_ + KVBLK - 1 > qlo) mask_tile(P0_, P1_, qm - kb_); } while (0)
    constexpr int NQL = 8;
#define SEAM_K0() do { VMWN(NQL); SWRITE_HK(0); SBAR(); } while (0)
    f32x16 pA0, pA1, pB0, pB1; float mnA, mnB, alA, alB; bf16x8 pa0, pa1, pa2, pa3;
    SWRITE_HV(0); SBAR();
    if (NT > 1) { SLOAD_H(cur.ko, cur.vo, KBASE(1)); }
    SBAR(); qkt<0>(pA0, pA1, K_lds, r32, hi, S.qr, cl, KBASE(0), cref);
    MASKT(pA0, pA1, 0); partialSM(pA0, pA1, m_reg, mnA, alA);
    if (NT > 1) { VMW(); SWRITE_H(1); }
    __syncthreads();
#define HALF_STEP(PX0, PX1, mnX, alX, PY0, PY1, alY, t, KB, VB, SB) do {                                                      \
        SBAR(); qkt<KB>(PX0, PX1, K_lds, r32, hi, S.qr, cl, KBASE(t), cref);                                                  \
        finishSM(PY0, PY1, alY, l_reg, pa0, pa1, pa2, pa3); SBAR();                                                           \
        if ((t) + 1 < NT) { SLOAD_H(cur.ko, cur.vo, KBASE((t) + 1)); SBAR(); }                                                \
        pv_tile<VB>(o, vb0, pa0, pa1, pa2, pa3); MASKT(PX0, PX1, (t)); partialSM(PX0, PX1, m_reg, mnX, alX);                 \
        __syncthreads();                                                                                                      \
        if ((t) + 1 < NT) { VMW(); SWRITE_H(SB); }                                                                            \
        RESC(alX); __syncthreads(); } while (0)
    for (int t = 1; t + 1 < NT; t += 2) {
        HALF_STEP(pB0, pB1, mnB, alB, pA0, pA1, alA, t, 1, 0, 0);
        HALF_STEP(pA0, pA1, mnA, alA, pB0, pB1, alB, t + 1, 0, 1, 1);
    }
    const bool even = (NT & 1) == 0;
    if (even) { SBAR(); qkt<1>(pB0, pB1, K_lds, r32, hi, S.qr, cl, KBASE(NT - 1), cref); SBAR(); }
    SLOAD_H(nxt.ko, nxt.vo, nxt.t0 * KVBLK); SBAR();
    { const unsigned qv = (unsigned)((wid * QBLK + r32) * QKV_LD + hi * 8) * 2u;
#pragma unroll
      for (int d0 = 0; d0 < 8; ++d0) S.qr[d0] = GLD8(zb, nxt.qo, qv + d0 * 32); }
    SBAR();
    finishSM(pA0, pA1, alA, l_reg, pa0, pa1, pa2, pa3); SBAR();
    pv_tile<0>(o, vb0, pa0, pa1, pa2, pa3);
    if (even) { MASKT(pB0, pB1, NT - 1); partialSM(pB0, pB1, m_reg, mnB, alB); __syncthreads(); RESC(alB);
        finishSM(pB0, pB1, alB, l_reg, pa0, pa1, pa2, pa3); SBAR(); pv_tile<1>(o, vb0, pa0, pa1, pa2, pa3); }
    SBAR(); SEAM_K0();
    if (hi == 0) li_l[r32] = l_reg; asm volatile("s_waitcnt lgkmcnt(0)" ::: "memory");
    float rli[16];
#pragma unroll
    for (int r = 0; r < 16; ++r) rli[r] = __builtin_amdgcn_rcpf(li_l[crow(r, hi)]);
    const unsigned ov = (unsigned)((wid * QBLK + 4 * hi) * O_LD + r32) * 2u;
    float gq[4];
#pragma unroll
    for (int d0 = 0; d0 < 4; ++d0) gq[d0] = og[cur.hh * DH + d0 * 32 + r32];
    float qs[16];
#pragma unroll
    for (int r = 0; r < 16; ++r) { const unsigned orow = (unsigned)(((r & 3) + 8 * (r >> 2)) * O_LD * 2); float q = 0.f;
#pragma unroll
        for (int d0 = 0; d0 < 4; ++d0) { const float v = o[d0][r] * rli[r]; q += v * v;
            const float vg = v * gq[d0], vn = swz_xor<1>(vg);
            if ((r32 & 1) == 0) *(unsigned*)(yb + (size_t)(cur.oo + orow + d0 * 64) + ov) = cvtpk(vg, vn); }
        qs[r] = q; }
    { const bool b0 = (r32 & 1) != 0, b1 = (r32 & 2) != 0, b2 = (r32 & 4) != 0, b3 = (r32 & 8) != 0;
      float a8[8], a4[4], a2[2];
#pragma unroll
      for (int i = 0; i < 8; ++i) { const float x = qs[2 * i] + swz_xor<1>(qs[2 * i]), y = qs[2 * i + 1] + swz_xor<1>(qs[2 * i + 1]); a8[i] = b0 ? y : x; }
#pragma unroll
      for (int i = 0; i < 4; ++i) { const float x = a8[2 * i] + swz_xor<2>(a8[2 * i]), y = a8[2 * i + 1] + swz_xor<2>(a8[2 * i + 1]); a4[i] = b1 ? y : x; }
#pragma unroll
      for (int i = 0; i < 2; ++i) { const float x = a4[2 * i] + swz_xor<4>(a4[2 * i]), y = a4[2 * i + 1] + swz_xor<4>(a4[2 * i + 1]); a2[i] = b2 ? y : x; }
      const float x = a2[0] + swz_xor<8>(a2[0]), y = a2[1] + swz_xor<8>(a2[1]); float tot = b3 ? y : x; tot += swz_xor<16>(tot);
      const int rr_ = r32 & 15;
      if (r32 < 16) ssq[(size_t)(cur.grow + wid * QBLK + ((rr_ & 3) + 8 * (rr_ >> 2)) + 4 * hi) * 8 + cur.hh] = tot; }
    __syncthreads();
#undef RESC
#undef KBASE
#undef MASKT
#undef SEAM_K0
#undef HALF_STEP
}
#undef VMW
#undef VMWN
#undef GLD8
#undef SLOAD_H
#undef SWRITE_HK
#undef SWRITE_HV
#undef SWRITE_H
#undef KSWZ
#undef SBAR
}

template <int MODE>
__device__ __forceinline__ void cvt_item(const float* W, int ldw, int K, bf16_t* WT, int rowadd, LAS float* scr, int kb, int nb, int lane, int krot = 0) {
    const int k0 = 64 * kb, n0 = 32 * nb, kd0 = (k0 + krot) & (K - 1);
#pragma unroll 8
    for (int i = 0; i < 32; ++i) { const int kk = 2 * i + (lane >> 5); scr[kk * 33 + (lane & 31)] = W[(size_t)(k0 + kk) * ldw + n0 + (lane & 31)]; }
    asm volatile("s_waitcnt lgkmcnt(0)" ::: "memory");
    const int c = lane & 7;
#pragma unroll
    for (int j = 0; j < 4; ++j) { const int n = (lane >> 3) + 8 * j; const LAS float* sp = scr + (8 * c) * 33 + n; const int nn = n0 + n;
        const int drow = rowadd + (MODE ? 8 * (nn >> 2) + (nn & 3) : nn);
        uint4 o; o.x = pk2(sp[0 * 33], sp[1 * 33]); o.y = pk2(sp[2 * 33], sp[3 * 33]); o.z = pk2(sp[4 * 33], sp[5 * 33]); o.w = pk2(sp[6 * 33], sp[7 * 33]);
        *(uint4*)(WT + (size_t)drow * K + kd0 + 8 * c) = o; }
    asm volatile("s_waitcnt lgkmcnt(0)" ::: "memory");
}

template <int MODE>
__device__ __forceinline__ void cvt_item8(const float* W, int ldw, int K, unsigned char* WT, int rowadd, LAS float* scr, int kb, int nb, int lane) {
    const int k0 = 64 * kb, n0 = 32 * nb;
#pragma unroll 8
    for (int i = 0; i < 32; ++i) { const int kk = 2 * i + (lane >> 5); scr[kk * 33 + (lane & 31)] = W[(size_t)(k0 + kk) * ldw + n0 + (lane & 31)]; }
    asm volatile("s_waitcnt lgkmcnt(0)" ::: "memory");
    const int c = lane & 7;
#pragma unroll
    for (int j = 0; j < 4; ++j) { const int n = (lane >> 3) + 8 * j; const LAS float* sp = scr + (8 * c) * 33 + n; const int nn = n0 + n;
        const int drow = rowadd + (MODE ? 8 * (nn >> 2) + (nn & 3) : nn);
        uint2 o; o.x = pk4_fp8(sp[0 * 33] * W8_SCALE, sp[1 * 33] * W8_SCALE, sp[2 * 33] * W8_SCALE, sp[3 * 33] * W8_SCALE); o.y = pk4_fp8(sp[4 * 33] * W8_SCALE, sp[5 * 33] * W8_SCALE, sp[6 * 33] * W8_SCALE, sp[7 * 33] * W8_SCALE);
        *(uint2*)(WT + (size_t)drow * K + k0 + 8 * c) = o; }
    asm volatile("s_waitcnt lgkmcnt(0)" ::: "memory");
}

struct Args { const float* in[29]; float* out; unsigned char* ws; int ph_lo, ph_hi, li, pad; };

__global__ void __launch_bounds__(512, 2) fwd_kernel(Args a) {
    extern __shared__ __attribute__((aligned(16))) unsigned char lds_raw[];
    LAS unsigned char* const lds0_ = (LAS unsigned char*)lds_raw;
    volatile LAS unsigned* MISC = (volatile LAS unsigned*)(lds0_ + MISC_OFF);
    const int wave0 = __builtin_amdgcn_readfirstlane((int)threadIdx.x >> 6);
    const int tid0 = threadIdx.x;
    const int wg0 = blockIdx.x, nwg0 = gridDim.x;
#define PHASE_IDS const __attribute__((address_space(4))) Args* ap_ = (const __attribute__((address_space(4))) Args*)__builtin_amdgcn_kernarg_segment_ptr(); int wg = wg0, nwg = nwg0; LAS unsigned char* lds = lds0_; asm volatile("" : "+s"(ap_), "+s"(wg), "+s"(nwg), "+s"(lds)); LAS float* const ldsf = (LAS float*)lds; (void)ldsf; unsigned char* ws = ap_->ws; unsigned* const ctl = (unsigned*)(ws + WS_CTL); (void)ctl; int zv_ = 0; asm volatile("" : "+v"(zv_)); int tid = (wave0 << 6) | (int)__builtin_amdgcn_mbcnt_hi(~0u, __builtin_amdgcn_mbcnt_lo(~0u, (unsigned)zv_)); asm volatile("" : "+v"(tid)); const int lane = tid & 63, wave = __builtin_amdgcn_readfirstlane(tid >> 6); (void)lane; (void)wave;
#define NRMP ((unsigned*)(ws + WS_CTL + 600 * 1024) + l * 512)
#define ASG ((int*)(ws + WS_ASG))
#define GATE ((float*)(ws + WS_GATE))
#define FL ((float*)(ws + WS_F))
#define TOKL ((int*)(ws + WS_TOKL))
#define XB ((bf16_t*)(ws + WS_X))
#define HB ((bf16_t*)(ws + WS_H))
#define Z ((bf16_t*)(ws + WS_BIG + BIG_Z))
#define Y ((bf16_t*)(ws + WS_BIG + BIG_Y))
#define PE ((bf16_t*)(ws + WS_BIG + BIG_PE))
#define Y2 ((bf16_t*)(ws + WS_BIG))
#define PB ((bf16_t*)(ws + WS_PB))
#define WR ((bf16_t*)(ws + WS_W))
#define WIN_T (WR + WO_WIN)
#define WO_T (WR + WO_WO)
#define W13_T (WR + WO_W13)
#define W2_T (WR + WO_W2)
#define WPE_T (WR + WO_WPE)
#define WPG_T (WR + WO_WPG)
#define WF_T (WR + WO_WF)
#define U1 (ap_->out)

    if (tid0 < 32) MISC[tid0] = 0u;
    __syncthreads();
    const int lo = a.ph_lo, hi = a.ph_hi;
    XcdBarrier bar; bar.bar = (unsigned*)(a.ws + WS_CTL) + CW_BAR + a.li * CW_BAR_STRIDE; bar.x = 0; bar.st = MISC + 8;
    if (hi - lo > 1) bar = xcd_barrier_post((unsigned*)(a.ws + WS_CTL) + CW_BAR + a.li * CW_BAR_STRIDE, MISC + 8);
#ifndef PHMASK
#define PHMASK 0x3ff
#endif
#define IN(k) ((((PHMASK) >> ((k) == 0 ? 0 : 1 + ((k) - 1) % PPL)) & 1) && lo <= (k) && (k) < hi)
#define SEAM(k) do { if ((k) + 1 < hi) { XcdBarrier bl_ = bar; asm volatile("" : "+s"(bl_.bar), "+s"(bl_.x)); xcd_barrier(bl_); } } while (0)

    if (IN(0)) {
        PHASE_IDS
        const float4* x4 = (const float4*)ap_->in[0]; uint2* o2 = (uint2*)XB;
        for (size_t i = (size_t)wg * 512 + tid; i < (size_t)T * D / 4; i += (size_t)nwg * 512) { const float4 v = x4[i]; uint2 o; o.x = pk2(v.x, v.y); o.y = pk2(v.z, v.w); o2[i] = o; ((unsigned*)(ws + WS_XB8))[i] = pk4_fp8(v.x, v.y, v.z, v.w); }
        const float4* p4 = (const float4*)ap_->in[1]; uint2* q2 = (uint2*)PB;
        for (size_t i = (size_t)wg * 512 + tid; i < (size_t)DEPTH * T * DPLE / 4; i += (size_t)nwg * 512) { const float4 v = p4[i]; uint2 o; o.x = pk2(v.x, v.y); o.y = pk2(v.z, v.w); q2[i] = o; }
        SEAM(0);
    }

#define w_in (ap_->in[2] + (size_t)l * D * N_IN)
#define b_f (ap_->in[3] + l * AH)
#define conv_w (ap_->in[4] + (size_t)l * CONV_W * CONV_CH)
#define conv_b (ap_->in[5] + l * CONV_CH)
#define conv_ln_g (ap_->in[6] + l * CONV_CH)
#define conv_ln_b (ap_->in[7] + l * CONV_CH)
#define gm_ln_g (ap_->in[8] + l * GM_CH)
#define gm_ln_b (ap_->in[9] + l * GM_CH)
#define w_sp (ap_->in[10] + (size_t)l * 4 * CHUNK * CHUNK)
#define b_sp (ap_->in[11] + l * 4 * CHUNK)
#define out_g (ap_->in[12] + l * D)
#define w_o (ap_->in[13] + (size_t)l * D * D)
#define ln1_g (ap_->in[14] + l * D)
#define ln1_b (ap_->in[15] + l * D)
#define w_r (ap_->in[16] + (size_t)l * D * NE)
#define r_bias (ap_->in[17] + l * NE)
#define w_e1 (ap_->in[18] + (size_t)l * NE * D * DE)
#define w_e3 (ap_->in[19] + (size_t)l * NE * D * DE)
#define w_e2 (ap_->in[20] + (size_t)l * NE * DE * D)
#define w_sh1 (ap_->in[21] + (size_t)l * D * DE)
#define w_sh3 (ap_->in[22] + (size_t)l * D * DE)
#define w_sh2 (ap_->in[23] + (size_t)l * DE * D)
#define w_pe (ap_->in[24] + (size_t)l * DPLE * D)
#define w_pg (ap_->in[25] + (size_t)l * D * D)
#define b_pg (ap_->in[26] + l * D)
#define ln2_g (ap_->in[27] + l * D)
#define ln2_b (ap_->in[28] + l * D)
#define pin (ap_->in[1] + (size_t)l * T * DPLE)
#define cntg (ctl + CW_CNT + l * 64 * 64)
    for (int l = 0; l < DEPTH; ++l) {
        const int pb = 1 + PPL * l;

        if (IN(pb + 0)) {
            PHASE_IDS
            LAS float* scr = ldsf + wave * (64 * 33);
            const int gw = wg * 8 + wave, NGW = nwg * 8;
            constexpr int I_IN = 32 * 64 + 32 * 96, I_O = 32 * 64, I_E13 = NE * 2 * 32 * 16, I_S13 = 2 * 32 * 16, I_E2 = NE * 8 * 64, I_S2 = 8 * 64, I_PE = 4 * 64, I_PG = 32 * 64;
            constexpr int NITEMS = I_IN + I_O + I_E13 + I_S13 + I_E2 + I_S2 + I_PE + I_PG;
            for (int it = gw; it < NITEMS; it += NGW) {
                int r = it;
                if (r < 32 * 64) { cvt_item<0>(w_in, N_IN, D, WIN_T, 0, scr, r / 64, r % 64, lane); continue; }
                if (r < I_IN) { const int r2 = r - 32 * 64; cvt_item8<0>(w_in + OFF_Q, N_IN, D, (unsigned char*)(WIN_T + (size_t)OFF_Q * D), 0, scr, r2 / 96, r2 % 96, lane); continue; } r -= I_IN;
                if (r < I_O) { cvt_item<0>(w_o, D, D, WO_T, 0, scr, r / 64, r % 64, lane, 1024); continue; } r -= I_O;
                if (r < I_E13) { const int e = r >> 10, r2 = r & 1023, which = r2 >> 9, r3 = r2 & 511;
                    if (USE_FP8) cvt_item8<1>((which ? w_e3 : w_e1) + (size_t)e * D * DE, DE, D, (unsigned char*)W13_T, e * 1024 + 4 * which, scr, r3 >> 4, r3 & 15, lane); else cvt_item<1>((which ? w_e3 : w_e1) + (size_t)e * D * DE, DE, D, W13_T, e * 1024 + 4 * which, scr, r3 >> 4, r3 & 15, lane); continue; } r -= I_E13;
                if (r < I_S13) { const int which = r >> 9, r3 = r & 511; if (USE_FP8) cvt_item8<1>(which ? w_sh3 : w_sh1, DE, D, (unsigned char*)W13_T, 64 * 1024 + 4 * which, scr, r3 >> 4, r3 & 15, lane); else cvt_item<1>(which ? w_sh3 : w_sh1, DE, D, W13_T, 64 * 1024 + 4 * which, scr, r3 >> 4, r3 & 15, lane); continue; } r -= I_S13;
                if (r < I_E2) { const int e = r >> 9, r2 = r & 511; if (USE_FP8) cvt_item8<0>(w_e2 + (size_t)e * DE * D, D, DE, (unsigned char*)W2_T, e * D, scr, r2 >> 6, r2 & 63, lane); else cvt_item<0>(w_e2 + (size_t)e * DE * D, D, DE, W2_T, e * D, scr, r2 >> 6, r2 & 63, lane); continue; } r -= I_E2;
                if (r < I_S2) { if (USE_FP8) cvt_item8<0>(w_sh2, D, DE, (unsigned char*)W2_T, 64 * D, scr, r >> 6, r & 63, lane); else cvt_item<0>(w_sh2, D, DE, W2_T, 64 * D, scr, r >> 6, r & 63, lane); continue; } r -= I_S2;
                if (r < I_PE) { cvt_item<0>(w_pe, D, DPLE, WPE_T, 0, scr, r >> 6, r & 63, lane); continue; } r -= I_PE;
                if (USE_FP8) cvt_item8<0>(w_pg, D, D, (unsigned char*)WPG_T, 0, scr, r >> 6, r & 63, lane); else cvt_item<0>(w_pg, D, D, WPG_T, 0, scr, r >> 6, r & 63, lane);
            }
            if (wg == 0) for (int i = tid; i < 8 * D; i += 512) { const int h = i / D, k = i % D; WF_T[i] = (bf16_t)f2bf(w_in[(size_t)k * N_IN + OFF_F + h]); }
            if (wg < 128) { const int i = wg * 512 + tid; const int t_ = (i >> 7) & 127, s_ = i & 127; (WR + WO_WSP)[i] = (bf16_t)(s_ <= t_ ? f2bf(w_sp[i]) : 0u); }
            if (wg < 256) for (int i = wg * 512 + tid; i < NE * D; i += 256 * 512) { const int e = i / D, k = i % D; const float w = w_r[(size_t)k * NE + e]; const unsigned hb = f2bf(w); (WR + WO_WR)[i] = (bf16_t)hb; (WR + WO_WR)[NE * D + i] = (bf16_t)f2bf(w - __uint_as_float(hb << 16)); }
            SEAM(pb + 0);
        }

        if (IN(pb + 1)) {
            PHASE_IDS
            { g8::DenseSched S{(const char*)XB, (const char*)WIN_T, nullptr, T / 256, OFF_Q / 256, D, nwg, wg}; g8::EpiZ E{Z, 0, nullptr};
              g8::gemm_phase(tid, lds, D, S, E); }
            { int tid2 = tid; asm volatile("" : "+v"(tid2));
              g8::MoeSched S{0, 0, 0, 0, 0, (const char*)(ws + WS_XB8), (const char*)(WIN_T + (size_t)OFF_Q * D), 0u, 0u, nullptr, T / 256, (ZW - OFF_Q) / 256, 0u, D / 2, nwg, wg}; g8::EpiZ E{Z, OFF_Q, NRMP};
              g8::gemm_phase<g8::EpiZ, g8::MoeSched, true>(tid2, lds, D / 2, S, E); }
            { const int fr = lane & 15, fq = lane >> 4;
              for (int tile = wg * 8 + wave; tile < T / 16; tile += nwg * 8) {
                  const bf16_t* ap = XB + (size_t)(tile * 16 + fr) * D + fq * 8; const bf16_t* bp = WF_T + (size_t)(fr & 7) * D + fq * 8;
                  f32x4 acc = {0.f, 0.f, 0.f, 0.f};
#pragma unroll 8
                  for (int ks = 0; ks < D / 32; ++ks) { const g8::bf16x8 av = *(const g8::bf16x8*)(ap + ks * 32); g8::bf16x8 bv = *(const g8::bf16x8*)(bp + ks * 32);
                      if (fr >= 8) bv = (g8::bf16x8){0, 0, 0, 0, 0, 0, 0, 0};
                      acc = __builtin_amdgcn_mfma_f32_16x16x32_bf16(bv, av, acc, 0, 0, 0); }
                  if (fq < 2) *(f32x4*)(FL + (size_t)(tile * 16 + fr) * 8 + 4 * fq) = acc; } }
            SEAM(pb + 1);
        }

        if (IN(pb + 2)) {
            PHASE_IDS
            constexpr int NGM = NB * (S / CHUNK);
            {
                LAS char* ldsa = (LAS char*)lds; LAS float* cl = (LAS float*)(ldsa + att::LDS_C); LAS float* wtot = cl + S; const char* zb = (const char*)Z; char* yb = (char*)Y;
                constexpr int NIT = NB * AH * (att::NQB / 2);
#define FOX_REF(L_, pass_, R_, prune_) do { const int bh_ = (L_) >> 3, x_ = (L_) & 7, b_ = bh_ >> 3, h_ = bh_ & 7, qb_ = (pass_) ? att::NQB - 1 - x_ : x_; const unsigned zo_ = (unsigned)(b_ * S) * (unsigned)(ZW * 2) + (unsigned)(h_ * HD * 2); \
        (R_).qo = zo_ + OFF_Q * 2 + (unsigned)(qb_ * att::QB) * (unsigned)(ZW * 2); (R_).ko = zo_ + OFF_K * 2; (R_).vo = zo_ + OFF_V * 2; (R_).oo = (unsigned)(b_ * S + qb_ * att::QB) * (unsigned)(D * 2) + (unsigned)((YC_ATT + h_ * HD) * 2); (R_).P0 = qb_ * att::QB; (R_).hh = h_; (R_).grow = b_ * S + qb_ * att::QB; (R_).t0 = 0; \
        if (prune_) { const float thr_ = FOX_RFL(cl[(R_).P0]) + thr_add; int lo_ = 0, hi_ = (R_).P0 / att::KVBLK;     \
            while (lo_ < hi_) { const int mid_ = (lo_ + hi_ + 1) >> 1; if (FOX_RFL(cl[att::KVBLK * mid_ - 1]) > thr_) lo_ = mid_; else hi_ = mid_ - 1; } (R_).t0 = lo_; } } while (0)
#define FOX_RFL(x_) __int_as_float(__builtin_amdgcn_readfirstlane(__float_as_int(x_)))
#define FOX_CUMSUM(L_) do { int t2_ = tid; asm volatile("" : "+v"(t2_)); const int lane2_ = t2_ & 63, wave2_ = __builtin_amdgcn_readfirstlane(t2_ >> 6); const int bh_ = (L_) >> 3, b_ = bh_ >> 3, h_ = bh_ & 7; const float bfh_ = b_f[h_]; const float* fp_ = FL + (size_t)b_ * S * 8 + h_; float loc_[8]; float run_ = 0.f; \
        _Pragma("unroll") for (int j_ = 0; j_ < 8; ++j_) { const float x_ = fp_[(size_t)(t2_ * 8 + j_) * 8] + bfh_; run_ += fminf(x_, 0.f) - log1pf(__expf(-fabsf(x_))); loc_[j_] = run_; } \
        float v_ = run_; _Pragma("unroll") for (int o_ = 1; o_ < 64; o_ <<= 1) { const float n_ = lane_up(v_, lane2_, o_); if (lane2_ >= o_) v_ += n_; } \
        if (lane2_ == 63) wtot[wave2_] = v_; __syncthreads(); float woff_ = 0.f; for (int w2_ = 0; w2_ < wave2_; ++w2_) woff_ += wtot[w2_]; const float off_ = woff_ + v_ - run_; \
        _Pragma("unroll") for (int j_ = 0; j_ < 8; ++j_) cl[t2_ * 8 + j_] = loc_[j_] + off_; \
        { unsigned* nq_ = NRMP + bh_ * 4; unsigned* nk_ = NRMP + (64 + bh_) * 4; float q2_ = 0.f, k2_ = 0.f; \
          _Pragma("unroll") for (int w_ = 0; w_ < 4; ++w_) { q2_ += __uint_as_float(xb_ld(nq_ + w_)); k2_ += __uint_as_float(xb_ld(nk_ + w_)); } \
          thr_add = 2.f * 1.02f * att::SCALE * sqrtf(q2_ * k2_) + 28.f; } \
        __syncthreads(); } while (0)
                int hm_wg = (wg >> 3) & 7;
                if ((nwg & 63) == 0) { const int h_ = hm_wg; const float bh_ = b_f[h_]; int rk_ = 0;
#pragma unroll
                    for (int j = 0; j < 8; ++j) { const float bj_ = b_f[j]; rk_ += (bj_ > bh_ || (bj_ == bh_ && j < h_)) ? 1 : 0; }
#pragma unroll
                    for (int i = 0; i < 8; ++i) { const float bi_ = b_f[i]; int r_ = 0;
#pragma unroll
                        for (int j = 0; j < 8; ++j) { const float bj_ = b_f[j]; r_ += (bj_ > bi_ || (bj_ == bi_ && j < i)) ? 1 : 0; }
                        if (r_ == 7 - rk_) hm_wg = i; }
                    hm_wg = __builtin_amdgcn_readfirstlane(hm_wg); }
#define FOX_ITEM(L_) (((((L_) / nwg) & 1) == 0 || (nwg & 7) != 0) ? (L_) : (((L_) & ~63) | (((nwg & 63) == 0 ? hm_wg : (((L_) >> 3) & 7)) << 3) | (((L_) & 7) ^ 7)))
                int L = wg, pass = 0;
                if (L < NIT) {
                    att::Seam Sm; att::BlockRef cur, nxt; float thr_add = 0.f;
                    FOX_CUMSUM(FOX_ITEM(L)); FOX_REF(FOX_ITEM(L), 0, cur, true);
                    att::fox_prime(tid, cur, zb, ldsa, Sm);
                    for (;;) {
                        const bool more_pass = pass == 0, more_item = L + nwg < NIT, last = !more_pass && !more_item;
                        int Ln = L, passn = pass + 1; if (!more_pass) { passn = 0; Ln = more_item ? L + nwg : L; }
                        if (last) nxt = cur; else FOX_REF(FOX_ITEM(Ln), passn, nxt, passn == 1);
                        att::fox_block(tid, cur, nxt, zb, yb, out_g + 1024, (float*)(ws + WS_SSQ), ldsa, Sm);
                        if (last) break;
                        if (passn == 0) FOX_CUMSUM(FOX_ITEM(Ln));
                        cur = nxt; L = Ln; pass = passn;
                    }
                }
#undef FOX_REF
#undef FOX_ITEM
#undef FOX_CUMSUM
#undef FOX_RFL
            }
            __syncthreads();
            for (int u = wg; u < NGM; u += nwg) {
                __syncthreads();
                {
                    const int b = u / (S / CHUNK), n = u % (S / CHUNK); const size_t row0 = (size_t)b * S + n * CHUNK;
                    constexpr int VRS = 272;
                    LAS unsigned char* vt = lds;
                    LAS float* st = (LAS float*)(lds + 4 * 128 * VRS);
                    static_assert(4 * 128 * VRS + 1024 <= MISC_OFF, "gMLP LDS map");
#pragma unroll 8
                    for (int i = 0; i < 16; ++i) { const int sp = wave * 16 + i; const uint4 xv = *(const uint4*)(Z + (row0 + sp) * ZW + 1536 + lane * 8);
                        const float x[8] = {bflo(xv.x), bfhi(xv.x), bflo(xv.y), bfhi(xv.y), bflo(xv.z), bfhi(xv.z), bflo(xv.w), bfhi(xv.w)}; float sum = 0.f;
#pragma unroll
                        for (int j = 0; j < 8; ++j) sum += x[j];
                        const float mean = wave_sum(sum) * (1.f / 512.f); float q = 0.f;
#pragma unroll
                        for (int j = 0; j < 8; ++j) { const float dd = x[j] - mean; q += dd * dd; }
                        const float rstd = rsqrtf(wave_sum(q) * (1.f / 512.f) + LN_EPS);
                        if (lane == 0) { st[sp * 2] = mean; st[sp * 2 + 1] = rstd; } }
                    __syncthreads();
#pragma unroll 4
                    for (int it = 0; it < 16; ++it) { const int q = it * 512 + tid, c8 = q >> 7, sp = q & 127; const uint4 xv = *(const uint4*)(Z + (row0 + sp) * ZW + 1536 + c8 * 8);
                        const float mean = st[sp * 2], rstd = st[sp * 2 + 1]; const float4 g0 = *(const float4*)(gm_ln_g + c8 * 8), g1 = *(const float4*)(gm_ln_g + c8 * 8 + 4), b0 = *(const float4*)(gm_ln_b + c8 * 8), b1 = *(const float4*)(gm_ln_b + c8 * 8 + 4);
                        const float x[8] = {bflo(xv.x), bfhi(xv.x), bflo(xv.y), bfhi(xv.y), bflo(xv.z), bfhi(xv.z), bflo(xv.w), bfhi(xv.w)};
                        const float gg[8] = {g0.x, g0.y, g0.z, g0.w, g1.x, g1.y, g1.z, g1.w}, bb[8] = {b0.x, b0.y, b0.z, b0.w, b1.x, b1.y, b1.z, b1.w};
                        LAS unsigned char* dst = vt + (c8 * 8) * VRS + sp * 2;
#pragma unroll
                        for (int j = 0; j < 8; ++j) *(LAS bf16_t*)(dst + j * VRS) = (bf16_t)f2bf((x[j] - mean) * rstd * gg[j] + bb[j]); }
                    __syncthreads();
                    const int fr = lane & 15, fq = lane >> 4; const int t = wave * 16 + fr;
                    const bf16_t* WSP = WR + WO_WSP;
                    unsigned ypk[4][8][2]; float ss = 0.f;
#pragma unroll
                    for (int h = 0; h < 4; ++h) {
                        f32x4 acc[8];
#pragma unroll
                        for (int cb = 0; cb < 8; ++cb) acc[cb] = (f32x4){0.f, 0.f, 0.f, 0.f};
#pragma unroll
                        for (int ks = 0; ks < 4; ++ks) { const g8::bf16x8 wv = *(const g8::bf16x8*)(WSP + (size_t)(h * 128 + t) * 128 + ks * 32 + fq * 8);
#pragma unroll
                            for (int cb = 0; cb < 8; ++cb) { const g8::bf16x8 xv = *(const LAS g8::bf16x8*)(vt + (h * 128 + cb * 16 + fr) * VRS + (ks * 32 + fq * 8) * 2);
                                acc[cb] = __builtin_amdgcn_mfma_f32_16x16x32_bf16(xv, wv, acc[cb], 0, 0, 0); } }
                        const float bs = b_sp[h * 128 + t];
#pragma unroll
                        for (int cb = 0; cb < 8; ++cb) { const uint2 uv = *(const uint2*)(Z + (row0 + t) * ZW + 1024 + h * 128 + cb * 16 + fq * 4);
                            const float y0 = bflo(uv.x) * (acc[cb][0] + bs), y1 = bfhi(uv.x) * (acc[cb][1] + bs), y2 = bflo(uv.y) * (acc[cb][2] + bs), y3 = bfhi(uv.y) * (acc[cb][3] + bs);
                            ss += (y0 * y0 + y1 * y1) + (y2 * y2 + y3 * y3); ypk[h][cb][0] = pk2(y0, y1); ypk[h][cb][1] = pk2(y2, y3); }
                    }
                    ss += swz_xor<16>(ss); { const auto rr = __builtin_amdgcn_permlane32_swap(__float_as_uint(ss), __float_as_uint(ss), false, false); ss = __uint_as_float(rr[0]) + __uint_as_float(rr[1]); }
                    const float rr_ = rsqrtf(ss * (1.f / 512.f) + LN_EPS);
#pragma unroll
                    for (int h = 0; h < 4; ++h)
#pragma unroll
                        for (int cb = 0; cb < 8; ++cb) { const int c = 512 + h * 128 + cb * 16 + fq * 4; const float4 og = *(const float4*)(out_g + c);
                            uint2 o; o.x = pk2(bflo(ypk[h][cb][0]) * rr_ * og.x, bfhi(ypk[h][cb][0]) * rr_ * og.y); o.y = pk2(bflo(ypk[h][cb][1]) * rr_ * og.z, bfhi(ypk[h][cb][1]) * rr_ * og.w);
                            *(uint2*)(Y + (row0 + t) * D + (YC_GMLP - 512) + c) = o; }
                }
            }
            for (int u = wg; u < T / 64; u += nwg) {
                __syncthreads();
                {
                    const int b = u / (S / 64), s0 = (u % (S / 64)) * 64; const int cp = tid & 255, ph = __builtin_amdgcn_readfirstlane(tid >> 8);
                    LAS float* cv = ldsf;
                    { f32x2 acc[32], wv[31]; const f32x2 cb2 = *(const f32x2*)(conv_b + 2 * cp); const char* cwb = (const char*)conv_w;
#pragma unroll
                      for (int j = 0; j < 31; ++j) { const char* pj = cwb + j * 2048; asm volatile("" : "+s"(pj)); wv[j] = *(const f32x2*)(pj + (unsigned)(8 * cp)); }
#pragma unroll
                      for (int t = 0; t < 32; ++t) acc[t] = cb2;
                      const int p0 = s0 + 32 * ph - 30;
#pragma unroll
                      for (int i = 0; i < 62; ++i) { f32x2 hv = {0.f, 0.f}; const int p = p0 + i;
                          if (p >= 0) { const char* zp = (const char*)Z + ((size_t)b * S + p) * (ZW * 2); const unsigned av = *(const unsigned*)(zp + (unsigned)(4 * cp)), gv = *(const unsigned*)(zp + 1024 + (unsigned)(4 * cp));
                              hv[0] = bflo(av) * g8::fast_sigmoid(bflo(gv)); hv[1] = bfhi(av) * g8::fast_sigmoid(bfhi(gv)); }
#pragma unroll
                          for (int t = (i - 30 > 0 ? i - 30 : 0); t <= (i < 31 ? i : 31); ++t) acc[t] += wv[i - t] * hv;
                          if ((i & 15) == 15) asm volatile("" ::: "memory"); }
#pragma unroll
                      for (int t = 0; t < 32; ++t) *(LAS f32x2*)(cv + (32 * ph + t) * 512 + 2 * cp) = acc[t]; }
                    __syncthreads();
#pragma unroll 1
                    for (int i = 0; i < 8; ++i) { const int t = wave * 8 + i; const f32x4 x0 = *(const LAS f32x4*)(cv + t * 512 + lane * 8), x1 = *(const LAS f32x4*)(cv + t * 512 + lane * 8 + 4);
                        float x[8] = {x0[0], x0[1], x0[2], x0[3], x1[0], x1[1], x1[2], x1[3]}; float sum = 0.f;
#pragma unroll
                        for (int j = 0; j < 8; ++j) sum += x[j];
                        const float mean = wave_sum(sum) * (1.f / 512.f); float q = 0.f;
#pragma unroll
                        for (int j = 0; j < 8; ++j) { const float dd = x[j] - mean; q += dd * dd; }
                        const float rstd = rsqrtf(wave_sum(q) * (1.f / 512.f) + LN_EPS); float ss = 0.f;
                        const float4 g0 = *(const float4*)(conv_ln_g + lane * 8), g1 = *(const float4*)(conv_ln_g + lane * 8 + 4), b0 = *(const float4*)(conv_ln_b + lane * 8), b1 = *(const float4*)(conv_ln_b + lane * 8 + 4);
                        const float gg[8] = {g0.x, g0.y, g0.z, g0.w, g1.x, g1.y, g1.z, g1.w}, bb[8] = {b0.x, b0.y, b0.z, b0.w, b1.x, b1.y, b1.z, b1.w};
#pragma unroll
                        for (int j = 0; j < 8; ++j) { const float yv = (x[j] - mean) * rstd * gg[j] + bb[j]; x[j] = yv * g8::fast_sigmoid(yv); ss += x[j] * x[j]; }
                        const float rr = rsqrtf(wave_sum(ss) * (1.f / 512.f) + LN_EPS);
                        const float4 o0 = *(const float4*)(out_g + lane * 8), o1 = *(const float4*)(out_g + lane * 8 + 4);
                        uint4 o; o.x = pk2(x[0] * rr * o0.x, x[1] * rr * o0.y); o.y = pk2(x[2] * rr * o0.z, x[3] * rr * o0.w); o.z = pk2(x[4] * rr * o1.x, x[5] * rr * o1.y); o.w = pk2(x[6] * rr * o1.z, x[7] * rr * o1.w);
                        *(uint4*)(Y + ((size_t)b * S + s0 + t) * D + YC_CONV + lane * 8) = o; }
                }
            }
            SEAM(pb + 2);
        }

        if (IN(pb + 4)) {
            PHASE_IDS
            { g8::DenseSched S{(const char*)Y, (const char*)WO_T, nullptr, T / 256, D / 256, D, nwg, wg}; g8::EpiU1 E{XB, U1, (const float*)(ws + WS_SSQ)};
              g8::gemm_phase(tid, lds, D, S, E); }
            { int tid2 = tid; asm volatile("" : "+v"(tid2));
              g8::DenseSched S{(const char*)(PB + (size_t)l * T * DPLE), (const char*)WPE_T, nullptr, T / 256, D / 256, DPLE, nwg, wg}; g8::EpiBf E{PE, D};
              g8::gemm_phase(tid2, lds, DPLE, S, E); }
            SEAM(pb + 4);
        }

        if (IN(pb + 5)) {
            PHASE_IDS
            constexpr int XRS = 4112;
            LAS unsigned char* xt = lds;
            LAS float* part = (LAS float*)lds;
            LAS int* a_e = (LAS int*)(lds + 32 * XRS);
            LAS int* a_lp = a_e + 1024; LAS float* a_g = (LAS float*)(a_lp + 1024);
            LAS int* lcnt = (LAS int*)(a_g + 1024); LAS int* lbase = lcnt + 64;
            static_assert(32 * XRS + 3 * 4096 + 512 <= MISC_OFF, "P5 LDS map");
            const bf16_t* WRT = WR + WO_WR;
            const int fr = lane & 15, fq = lane >> 4;
            if (tid < 64) lcnt[tid] = 0;
            uint2 raw[4][8];
#define P5_LOAD(tile_) do { _Pragma("unroll") for (int rr = 0; rr < 4; ++rr) { const bf16_t* rp_ = (const bf16_t*)U1 + ((size_t)(tile_) * 32 + wave * 4 + rr) * D + lane * 4; \
        _Pragma("unroll") for (int j = 0; j < 8; ++j) raw[rr][j] = *(const uint2*)(rp_ + j * 256); } } while (0)
            int ti = 0;
            for (int tile = wg; tile < T / 32 && ti < 4; tile += nwg, ++ti) {
                const int t0 = tile * 32;
                P5_LOAD(tile);
                __syncthreads();
                float mean[4], rstd[4];
#pragma unroll
                for (int rr = 0; rr < 4; ++rr) { float sum = 0.f;
#pragma unroll
                    for (int j = 0; j < 8; ++j) sum += (bflo(raw[rr][j].x) + bfhi(raw[rr][j].x)) + (bflo(raw[rr][j].y) + bfhi(raw[rr][j].y));
                    mean[rr] = wave_sum(sum) * (1.f / D); }
#define P5_OPAQUE() do { _Pragma("unroll") for (int rr = 0; rr < 4; ++rr) { _Pragma("unroll") for (int j = 0; j < 8; ++j) asm volatile("" : "+v"(raw[rr][j].x), "+v"(raw[rr][j].y)); } } while (0)
                P5_OPAQUE();
#pragma unroll
                for (int rr = 0; rr < 4; ++rr) { float q = 0.f; const float m = mean[rr];
#pragma unroll
                    for (int j = 0; j < 8; ++j) { const float a0_ = bflo(raw[rr][j].x) - m, a1_ = bfhi(raw[rr][j].x) - m, a2_ = bflo(raw[rr][j].y) - m, a3_ = bfhi(raw[rr][j].y) - m; q += (a0_ * a0_ + a1_ * a1_) + (a2_ * a2_ + a3_ * a3_); }
                    rstd[rr] = rsqrtf(wave_sum(q) * (1.f / D) + LN_EPS); }
                P5_OPAQUE();
#pragma unroll
                for (int j = 0; j < 8; ++j) { const int c = (j * 64 + lane) * 4; const float4 g = *(const float4*)(ln1_g + c), bb = *(const float4*)(ln1_b + c);
#pragma unroll
                    for (int rr = 0; rr < 4; ++rr) { const int lr = wave * 4 + rr; const size_t row = (size_t)t0 + lr; const float m = mean[rr], rs = rstd[rr];
                        uint2 o; o.x = pk2((bflo(raw[rr][j].x) - m) * rs * g.x + bb.x, (bfhi(raw[rr][j].x) - m) * rs * g.y + bb.y); o.y = pk2((bflo(raw[rr][j].y) - m) * rs * g.z + bb.z, (bfhi(raw[rr][j].y) - m) * rs * g.w + bb.w);
                        *(uint2*)(XB + row * D + c) = o; *(LAS g8::u32x2*)(xt + lr * XRS + c * 2) = (g8::u32x2){o.x, o.y};
                        if (USE_FP8) *(unsigned*)((unsigned char*)Z + row * D + c) = pk4_fp8(bflo(o.x), bfhi(o.x), bflo(o.y), bfhi(o.y)); }
                    if (j & 1) asm volatile("" ::: "memory"); }
                __syncthreads();
                f32x4 acc[2][4];
#pragma unroll
                for (int mb = 0; mb < 2; ++mb)
#pragma unroll
                    for (int n = 0; n < 4; ++n) acc[mb][n] = (f32x4){0.f, 0.f, 0.f, 0.f};
#pragma unroll 4
                for (int kk = 0; kk < 8; ++kk) { const int kof = (wave * 8 + kk) * 32 + fq * 8;
                    const g8::bf16x8 a0 = *(const LAS g8::bf16x8*)(xt + fr * XRS + kof * 2), a1 = *(const LAS g8::bf16x8*)(xt + (16 + fr) * XRS + kof * 2);
#pragma unroll
                    for (int n = 0; n < 4; ++n) { const g8::bf16x8 bh = *(const g8::bf16x8*)(WRT + (size_t)(16 * n + fr) * D + kof), bl = *(const g8::bf16x8*)(WRT + (size_t)(NE + 16 * n + fr) * D + kof);
                        acc[0][n] = __builtin_amdgcn_mfma_f32_16x16x32_bf16(bh, a0, acc[0][n], 0, 0, 0); acc[0][n] = __builtin_amdgcn_mfma_f32_16x16x32_bf16(bl, a0, acc[0][n], 0, 0, 0);
                        acc[1][n] = __builtin_amdgcn_mfma_f32_16x16x32_bf16(bh, a1, acc[1][n], 0, 0, 0); acc[1][n] = __builtin_amdgcn_mfma_f32_16x16x32_bf16(bl, a1, acc[1][n], 0, 0, 0); } }
                __syncthreads();
#pragma unroll
                for (int mb = 0; mb < 2; ++mb)
#pragma unroll
                    for (int n = 0; n < 4; ++n) *(LAS f32x4*)(part + ((wave * 2 + mb) * 4 + n) * 256 + lane * 4) = acc[mb][n];
                __syncthreads();
                const float rbias = r_bias[lane];
                float score[4], msel[4]; int ek[4];
#pragma unroll
                for (int r = 0; r < 4; ++r) {
                    const int tt = wave * 4 + r, mb = tt >> 4, frt = tt & 15; const int pofs = (mb * 4 + (lane >> 4)) * 256 + (((lane >> 2) & 3) * 16 + frt) * 4 + (lane & 3);
                    float logit = 0.f;
#pragma unroll
                    for (int w2 = 0; w2 < 8; ++w2) logit += part[w2 * 2048 + pofs];
                    score[r] = sigmoidf_(logit); const float sel = score[r] + rbias; const int g = lane >> 3;
                    int rk = 0;
#define RK_STEP(J) { const float o = shx<J>(sel, lane); const int ol = lane ^ J; rk += (o > sel || (o == sel && ol < lane)) ? 1 : 0; }
                    RK_STEP(1) RK_STEP(2) RK_STEP(3) RK_STEP(4) RK_STEP(5) RK_STEP(6) RK_STEP(7)
#undef RK_STEP
                    float gs = rk < 2 ? sel : 0.f; gs += swz_xor<1>(gs); gs += swz_xor<2>(gs); gs += swz_xor<4>(gs);
                    int grk = 0;
#define GK_STEP(J) { const float o = shx<8 * J>(gs, lane); const int og = g ^ J; grk += (o > gs || (o == gs && og < g)) ? 1 : 0; }
                    GK_STEP(1) GK_STEP(2) GK_STEP(3) GK_STEP(4) GK_STEP(5) GK_STEP(6) GK_STEP(7)
#undef GK_STEP
                    msel[r] = grk < 4 ? sel : -__builtin_inff(); ek[r] = 64;
                }
#pragma unroll 1
                for (int it = 0; it < TOPK; ++it) {
#pragma unroll
                    for (int r = 0; r < 4; ++r) { const float m = wave_max(msel[r]); const unsigned long long bal = __builtin_amdgcn_ballot_w64(msel[r] == m);
                        const int first = (int)__builtin_ctzll(bal); if (lane == first) { ek[r] = it; msel[r] = -__builtin_inff(); } } }
#pragma unroll
                for (int r = 0; r < 4; ++r) { const int tt = wave * 4 + r; const bool ch = ek[r] < TOPK;
                    const float gsum = wave_sum(ch ? score[r] : 0.f);
                    if (ch) { const int lp = atomicAdd((int*)(lcnt + lane), 1); const int idx = (ti * 32 + tt) * 8 + ek[r]; a_e[idx] = lane; a_lp[idx] = lp; a_g[idx] = score[r] / gsum * ROUTE_SCALE; } }
            }
#undef P5_LOAD
#undef P5_OPAQUE
            __syncthreads();
            if (tid < 64) { const int c = lcnt[tid]; int bs = 0; if (c > 0) bs = (int)atomicAdd(cntg + tid * 64, (unsigned)c); lbase[tid] = bs; }
            __syncthreads();
            for (int idx = tid; idx < ti * 256; idx += 512) { const int e = a_e[idx], pos = lbase[e] + a_lp[idx]; const int tok = (wg + (idx >> 8) * nwg) * 32 + ((idx >> 3) & 31);
                TOKL[e * T + pos] = tok; ASG[tok * 8 + (idx & 7)] = (e << 16) | pos; GATE[tok * 8 + (idx & 7)] = a_g[idx]; }
            SEAM(pb + 5);
        }

        if (IN(pb + 6)) {
            PHASE_IDS
            int vt, vr, vcn, ntr;
            { const int c = (int)cntg[lane * 64], tl_ = (c + 255) >> 8; int it = tl_, ir = c;
#pragma unroll
              for (int o = 1; o < 64; o <<= 1) { const int n1 = lane_up_i(it, lane, o), n2 = lane_up_i(ir, lane, o); if (lane >= o) { it += n1; ir += n2; } }
              vt = it - tl_; vr = ir - c; vcn = c; ntr = __builtin_amdgcn_readlane(it, 63); }
#if USE_FP8
            g8::MoeSched S{vt, vr, vcn, ntr, 4, (const char*)Z, (const char*)WR, (unsigned)(WO_W13 * 2), (unsigned)(1024u * D), TOKL, T / 256, D / 256, (unsigned)(WO_WPG * 2), D / 2, nwg, wg};
            g8::EpiUp E{HB, XB, PE, b_pg, (bf16_t*)(ws + WS_BASE), W8_INV, true};
            g8::gemm_phase<g8::EpiUp, g8::MoeSched, true>(tid, lds, D / 2, S, E);
#else
            g8::MoeSched S{vt, vr, vcn, ntr, 4, (const char*)XB, (const char*)WR, (unsigned)(WO_W13 * 2), (unsigned)(1024u * D * 2u), TOKL, T / 256, D / 256, (unsigned)(WO_WPG * 2), D, nwg, wg};
            g8::EpiUp E{HB, XB, PE, b_pg, (bf16_t*)(ws + WS_BASE), 1.f, false};
            g8::gemm_phase(tid, lds, D, S, E);
#endif
            SEAM(pb + 6);
        }

        if (IN(pb + 7)) {
            PHASE_IDS
            int vt, vr, vcn, ntr;
            { const int c = (int)cntg[lane * 64], tl_ = (c + 255) >> 8; int it = tl_, ir = c;
#pragma unroll
              for (int o = 1; o < 64; o <<= 1) { const int n1 = lane_up_i(it, lane, o), n2 = lane_up_i(ir, lane, o); if (lane >= o) { it += n1; ir += n2; } }
              vt = it - tl_; vr = ir - c; vcn = c; ntr = __builtin_amdgcn_readlane(it, 63); }
#if USE_FP8
            g8::MoeSched S{vt, vr, vcn, ntr, 8, (const char*)HB, (const char*)WR, (unsigned)(WO_W2 * 2), (unsigned)(D * DE), nullptr, 0, 0, 0u, DE / 2, nwg, wg};
            g8::EpiDown E{(unsigned char*)Y2, (unsigned char*)XB, W8_INV};
            g8::gemm_phase<g8::EpiDown, g8::MoeSched, true>(tid, lds, DE / 2, S, E);
#else
            g8::MoeSched S{vt, vr, vcn, ntr, 8, (const char*)HB, (const char*)WR, (unsigned)(WO_W2 * 2), (unsigned)(D * DE * 2), nullptr, 0, 0, 0u, DE, nwg, wg};
            g8::EpiDown E{(unsigned char*)Y2, (unsigned char*)XB, 1.f};
            g8::gemm_phase(tid, lds, DE, S, E);
#endif
            SEAM(pb + 7);
        }

        if (IN(pb + 8)) {
            PHASE_IDS
            LAS int* rsl = (LAS int*)(lds + 131072);
            __syncthreads();
            if (tid == 0) { int rs = 0; for (int e = 0; e < NE; ++e) { rsl[e] = rs; rs += (int)cntg[e * 64]; } }
            __syncthreads();
            const bool last = (l == DEPTH - 1);
            for (int row = wg * 8 + wave; row < T; row += nwg * 8) {
                float4 v[8];
#pragma unroll
                for (int j = 0; j < 8; ++j) { const uint2 bv = *(const uint2*)((const bf16_t*)(ws + WS_BASE) + (size_t)row * D + (j * 64 + lane) * 4); v[j] = make_float4(bflo(bv.x), bfhi(bv.x), bflo(bv.y), bfhi(bv.y)); const int sv = *(const int*)((const unsigned char*)XB + (size_t)row * (2 * D) + (j * 64 + lane) * 4);
                    v[j].x = fmaf(Y2_INV, __builtin_amdgcn_cvt_f32_fp8(sv, 0), v[j].x); v[j].y = fmaf(Y2_INV, __builtin_amdgcn_cvt_f32_fp8(sv, 1), v[j].y); v[j].z = fmaf(Y2_INV, __builtin_amdgcn_cvt_f32_fp8(sv, 2), v[j].z); v[j].w = fmaf(Y2_INV, __builtin_amdgcn_cvt_f32_fp8(sv, 3), v[j].w); }
#pragma unroll 4
                for (int k = 0; k < TOPK; ++k) { const int as = ASG[row * 8 + k]; const float g = GATE[row * 8 + k] * Y2_INV; const size_t slot = (size_t)rsl[as >> 16] + (as & 0xffff);
                    const unsigned char* yp = (const unsigned char*)Y2 + slot * D;
#pragma unroll
                    for (int j = 0; j < 8; ++j) { const int yv = *(const int*)(yp + (j * 64 + lane) * 4);
                        v[j].x = fmaf(g, __builtin_amdgcn_cvt_f32_fp8(yv, 0), v[j].x); v[j].y = fmaf(g, __builtin_amdgcn_cvt_f32_fp8(yv, 1), v[j].y);
                        v[j].z = fmaf(g, __builtin_amdgcn_cvt_f32_fp8(yv, 2), v[j].z); v[j].w = fmaf(g, __builtin_amdgcn_cvt_f32_fp8(yv, 3), v[j].w); } }
                float sum = 0.f;
#pragma unroll
                for (int j = 0; j < 8; ++j) sum += (v[j].x + v[j].y) + (v[j].z + v[j].w);
                const float mean = wave_sum(sum) * (1.f / D); float q = 0.f;
#pragma unroll
                for (int j = 0; j < 8; ++j) { v[j].x -= mean; v[j].y -= mean; v[j].z -= mean; v[j].w -= mean; q += (v[j].x * v[j].x + v[j].y * v[j].y) + (v[j].z * v[j].z + v[j].w * v[j].w); }
                const float rstd = rsqrtf(wave_sum(q) * (1.f / D) + LN_EPS);
#pragma unroll
                for (int j = 0; j < 8; ++j) { const int c = (j * 64 + lane) * 4; const float4 g = *(const float4*)(ln2_g + c), bb = *(const float4*)(ln2_b + c);
                    float4 y; y.x = v[j].x * rstd * g.x + bb.x; y.y = v[j].y * rstd * g.y + bb.y; y.z = v[j].z * rstd * g.z + bb.z; y.w = v[j].w * rstd * g.w + bb.w;
                    if (last) *(float4*)(ap_->out + (size_t)row * D + c) = y;
                    else { uint2 o; o.x = pk2(y.x, y.y); o.y = pk2(y.z, y.w); *(uint2*)(XB + (size_t)row * D + c) = o; *(unsigned*)(ws + WS_XB8 + (size_t)row * D + c) = pk4_fp8(bflo(o.x), bfhi(o.x), bflo(o.y), bfhi(o.y)); } }
            }
            SEAM(pb + 8);
        }
    }
#undef IN
#undef SEAM
#undef w_in
#undef b_f
#undef conv_w
#undef conv_b
#undef conv_ln_g
#undef conv_ln_b
#undef gm_ln_g
#undef gm_ln_b
#undef w_sp
#undef b_sp
#undef out_g
#undef w_o
#undef ln1_g
#undef ln1_b
#undef w_r
#undef r_bias
#undef w_e1
#undef w_e3
#undef w_e2
#undef w_sh1
#undef w_sh3
#undef w_sh2
#undef w_pe
#undef w_pg
#undef b_pg
#undef ln2_g
#undef ln2_b
#undef pin
}
}

#ifndef MK_ONE_LAUNCH
#define MK_ONE_LAUNCH 1
#endif
#ifndef PROBE_REP_MASK
#define PROBE_REP_MASK 0
#endif

extern "C" void kernel_launch(void* const* d_in, const int* in_sizes, int n_in, void* d_out, int out_size, void* d_ws, size_t ws_size, hipStream_t stream) {
    static int grid = 0;
    if (grid == 0) {
        if (n_in != 29 || in_sizes[0] != T * D || out_size != T * D || ws_size < WS_END) {
            fprintf(stderr, "kernel_launch: unexpected shapes (n_in %d, in0 %d, out %d, ws %zu; need ws >= %zu)\n", n_in, n_in > 0 ? in_sizes[0] : -1, out_size, ws_size, (size_t)WS_END); grid = -1; return; }
        int dev = 0, cus = 0, per_cu = 0;
        if (hipGetDevice(&dev) != hipSuccess || hipDeviceGetAttribute(&cus, hipDeviceAttributeMultiprocessorCount, dev) != hipSuccess) { grid = -1; return; }
        if (hipFuncSetAttribute((const void*)fwd_kernel, hipFuncAttributeMaxDynamicSharedMemorySize, LDS_BYTES) != hipSuccess) { fprintf(stderr, "kernel_launch: hipFuncSetAttribute failed\n"); grid = -1; return; }
        if (hipOccupancyMaxActiveBlocksPerMultiprocessor(&per_cu, (const void*)fwd_kernel, 512, LDS_BYTES) != hipSuccess || per_cu < 1) { fprintf(stderr, "kernel_launch: occupancy query says %d\n", per_cu); }
        (void)hipGetLastError();
        grid = cus;
    }
    if (grid < 0) return;
    (void)hipMemsetAsync((char*)d_ws + WS_CTL, 0, CTL_BYTES, stream);
    Args a{};
    for (int i = 0; i < 29; ++i) a.in[i] = (const float*)d_in[i];
    a.out = (float*)d_out; a.ws = (unsigned char*)d_ws;
#if PROBE_REP_MASK
    { int lo = 0; for (int ph = 0; ph < NPH; ++ph) { const int k = ph == 0 ? -1 : (ph - 1) % PPL; if (k >= 0 && ((PROBE_REP_MASK >> k) & 1)) {
          a.ph_lo = lo; a.ph_hi = ph + 1; hipLaunchKernelGGL(fwd_kernel, dim3(grid), dim3(512), LDS_BYTES, stream, a); lo = ph; ++a.li; } }
      a.ph_lo = lo; a.ph_hi = NPH; hipLaunchKernelGGL(fwd_kernel, dim3(grid), dim3(512), LDS_BYTES, stream, a); }
#elif MK_ONE_LAUNCH
    a.ph_lo = 0; a.ph_hi = NPH;
    hipLaunchKernelGGL(fwd_kernel, dim3(grid), dim3(512), LDS_BYTES, stream, a);
#else
    for (int ph = 0; ph < NPH; ++ph) { a.ph_lo = ph; a.ph_hi = ph + 1; hipLaunchKernelGGL(fwd_kernel, dim3(grid), dim3(512), LDS_BYTES, stream, a); }
#endif
}
```

```cpp
#include <hip/hip_runtime.h>
#include <cstdio>
#include <cstdint>

#define LAS __attribute__((address_space(3)))
typedef unsigned short bf16_t;
typedef float f32x4 __attribute__((ext_vector_type(4)));
typedef float f32x2 __attribute__((ext_vector_type(2)));

namespace {
constexpr int NB = 8, S = 4096, T = NB * S, D = 2048, DEPTH = 2;
constexpr int CONV_CH = 512, CONV_W = 31, GM_CH = 512, CHUNK = 128, AH = 8, HD = 128;
constexpr int OFF_GMLP = 1024, OFF_Q = 2048, OFF_K = 3072, OFF_V = 4096, OFF_F = 5120, N_IN = 5128;
constexpr int YC_ATT = 0, YC_CONV = 1024, YC_GMLP = 1536;
constexpr int ZW = 5120;
constexpr int NE = 64, TOPK = 8, DE = 512, DPLE = 256;
constexpr float ALPHA = 1.41421356237309515f;
constexpr float LN_EPS = 1e-5f, ROUTE_SCALE = 2.5f;
constexpr int PPL = 9;
constexpr int NPH = 1 + PPL * DEPTH;

constexpr size_t MiB = 1u << 20;
constexpr size_t WS_CTL = 0, CTL_BYTES = 1 * MiB;
constexpr size_t WS_ASG = 1 * MiB, WS_GATE = 2 * MiB, WS_F = 3 * MiB, WS_TOKL = 4 * MiB;
constexpr size_t WS_PB = 12 * MiB, WS_W = 44 * MiB, WS_X = 476 * MiB, WS_H = 604 * MiB, WS_BIG = 894 * MiB, WS_BASE = 1918 * MiB, WS_END = 2046 * MiB, WS_XB8 = WS_H + 160 * MiB;
constexpr size_t BIG_Z = 0, BIG_Y = 320 * MiB, BIG_PE = 448 * MiB;
constexpr size_t WO_WIN = 0, WO_WO = WO_WIN + (size_t)ZW * D, WO_W13 = WO_WO + (size_t)D * D, WO_W2 = WO_W13 + (size_t)65 * 1024 * D,
                 WO_WPE = WO_W2 + (size_t)65 * D * DE, WO_WPG = WO_WPE + (size_t)D * DPLE, WO_WF = WO_WPG + (size_t)D * D, WO_WR = WO_WF + (size_t)8 * D, WO_WSP = WO_WR + (size_t)2 * NE * D, WO_END = WO_WSP + (size_t)4 * CHUNK * CHUNK;
constexpr size_t WS_SSQ = WS_X - 1 * MiB;
static_assert(WO_END * 2 <= WS_SSQ - WS_W, "weight copies fit the W region");
constexpr int CW_BAR = 32768, CW_BAR_STRIDE = 4096, CW_CNT = 16384;

constexpr int LDS_BYTES = 147456, MISC_OFF = 145408;

__device__ __forceinline__ float bf2f(bf16_t h) { return __uint_as_float(((unsigned)h) << 16); }
__device__ __forceinline__ float bflo(unsigned u) { return __uint_as_float(u << 16); }
__device__ __forceinline__ float bfhi(unsigned u) { return __uint_as_float(u & 0xffff0000u); }
__device__ __forceinline__ unsigned f2bf(float f) { unsigned u = __float_as_uint(f); return (u + 0x7fffu + ((u >> 16) & 1u)) >> 16; }
__device__ __forceinline__ unsigned pk2(float lo, float hi) { return f2bf(lo) | (f2bf(hi) << 16); }
#ifndef USE_FP8
#define USE_FP8 1
#endif
constexpr float W8_SCALE = 64.f, W8_INV = 1.f / 64.f, Y2_SCALE = 16.f, Y2_INV = 1.f / 16.f;
__device__ __forceinline__ unsigned pk4_fp8(float a, float b, float c, float d) { int w = __builtin_amdgcn_cvt_pk_fp8_f32(a, b, 0, false); w = __builtin_amdgcn_cvt_pk_fp8_f32(c, d, w, true); return (unsigned)w; }
__device__ __forceinline__ float sigmoidf_(float x) { return 1.0f / (1.0f + __expf(-x)); }
__device__ __forceinline__ float gelu_tanh(float x) { const float u = 0.7978845608028654f * (x + 0.044715f * x * x * x); return 0.5f * x * (1.0f + tanhf(u)); }
template <int M> __device__ __forceinline__ float swz_xor(float v) { return __int_as_float(__builtin_amdgcn_ds_swizzle(__float_as_int(v), (M << 10) | 0x1f)); }
__device__ __forceinline__ float wave_sum(float v) {
    v += swz_xor<1>(v); v += swz_xor<2>(v); v += swz_xor<4>(v); v += swz_xor<8>(v); v += swz_xor<16>(v);
    const auto rr = __builtin_amdgcn_permlane32_swap(__float_as_uint(v), __float_as_uint(v), false, false);
    return __uint_as_float(rr[0]) + __uint_as_float(rr[1]);
}
__device__ __forceinline__ float wave_max(float v) {
    v = fmaxf(v, swz_xor<1>(v)); v = fmaxf(v, swz_xor<2>(v)); v = fmaxf(v, swz_xor<4>(v)); v = fmaxf(v, swz_xor<8>(v)); v = fmaxf(v, swz_xor<16>(v));
    const auto rr = __builtin_amdgcn_permlane32_swap(__float_as_uint(v), __float_as_uint(v), false, false);
    return fmaxf(__uint_as_float(rr[0]), __uint_as_float(rr[1]));
}
template <int M> __device__ __forceinline__ float shx(float v, int lane) {
    if constexpr (M < 32) return swz_xor<M>(v);
    else { const auto rr = __builtin_amdgcn_permlane32_swap(__float_as_uint(v), __float_as_uint(v), false, false); const float w = __uint_as_float(lane < 32 ? rr[1] : rr[0]);
        if constexpr ((M & 31) != 0) return swz_xor<(M & 31)>(w); else return w; }
}
__device__ __forceinline__ float lane_up(float v, int lane, int o) { return __int_as_float(__builtin_amdgcn_ds_bpermute(((lane - o) & 63) << 2, __float_as_int(v))); }
__device__ __forceinline__ int lane_up_i(int v, int lane, int o) { return __builtin_amdgcn_ds_bpermute(((lane - o) & 63) << 2, v); }

#define XB_TMO      128
#define XB_XCNT(j)  (256  + 64 * (j))
#define XB_XSUB(j)  (1280 + 64 * (j))
#define XB_XGEN(j)  (2304 + 64 * (j))
#define XB_TOP      3328
#define XB_TOPGEN   3392
#define XCD_BAR_WORDS 3456
#define XB_SPIN_CAP (1u << 22)
__device__ __forceinline__ unsigned xb_ld(unsigned* p)              { return __hip_atomic_load(p, __ATOMIC_RELAXED, __HIP_MEMORY_SCOPE_AGENT); }
__device__ __forceinline__ unsigned xb_add(unsigned* p, unsigned v) { return __hip_atomic_fetch_add(p, v, __ATOMIC_RELAXED, __HIP_MEMORY_SCOPE_AGENT); }
__device__ __forceinline__ unsigned xb_xcc_id() { return (unsigned)__builtin_amdgcn_s_getreg((3 << 11) | 20) & 0xFu; }
#define XB_SPIN(cond, bar) do { unsigned _sp = 0; while (cond) { __builtin_amdgcn_s_sleep(1); \
    if ((++_sp & 255u) == 0u) { if (xb_ld(&(bar)[XB_TMO])) break; if (_sp > XB_SPIN_CAP) { atomicAdd(&(bar)[XB_TMO], 1u); break; } } } } while (0)
struct XcdBarrier { unsigned* bar; unsigned x; volatile LAS unsigned* st; };
__device__ __forceinline__ XcdBarrier xcd_barrier_post(unsigned* bar, volatile LAS unsigned* st) {
    XcdBarrier b; b.bar = bar; b.x = xb_xcc_id(); b.st = st;
    if (threadIdx.x == 0) (void)xb_add(&bar[XB_XCNT(b.x)], 1u);
    return b;
}
__device__ __forceinline__ void xcd_barrier_complete(unsigned* bar, unsigned x, unsigned& nloc, unsigned& nx) {
    const unsigned G = gridDim.x * gridDim.y * gridDim.z;
    unsigned sum, cnt, mine, sp = 0u;
    for (;;) {
        sum = 0u; cnt = 0u; mine = 0u;
#pragma unroll
        for (unsigned j = 0; j < 16; ++j) { const unsigned c = xb_ld(&bar[XB_XCNT(j)]); sum += c; cnt += (c > 0u) ? 1u : 0u; }
        mine = xb_ld(&bar[XB_XCNT(x)]);
        if (sum == G) break;
        __builtin_amdgcn_s_sleep(1);
        if ((++sp & 255u) == 0u) { if (xb_ld(&bar[XB_TMO])) break; if (sp > XB_SPIN_CAP) { atomicAdd(&bar[XB_TMO], 1u); break; } }
    }
    nloc = mine > 0u ? mine : 1u; nx = cnt > 0u ? cnt : 1u;
}
__device__ __forceinline__ void xcd_barrier(const XcdBarrier& b) {
    asm volatile("s_waitcnt vmcnt(0)" ::: "memory");
    __syncthreads();
    if (threadIdx.x == 0) {
        unsigned* bar = b.bar;
        __builtin_amdgcn_s_waitcnt(0);
        unsigned nloc = b.st[0], nx = b.st[1];
        if (nloc == 0u) { xcd_barrier_complete(bar, b.x, nloc, nx); b.st[0] = nloc; b.st[1] = nx; }
        const unsigned old = xb_add(&bar[XB_XSUB(b.x)], 1u);
        const unsigned gen = old / nloc;
        if (old + 1u == (gen + 1u) * nloc) {
            __builtin_amdgcn_fence(__ATOMIC_RELEASE, "agent");
            asm volatile("s_waitcnt vmcnt(0)" ::: "memory");
            const unsigned og = xb_add(&bar[XB_TOP], 1u);
            const unsigned tg = og / nx;
            if (og + 1u == (tg + 1u) * nx) xb_add(&bar[XB_TOPGEN], 1u);
            else XB_SPIN(xb_ld(&bar[XB_TOPGEN]) == tg, bar);
            __builtin_amdgcn_fence(__ATOMIC_ACQUIRE, "agent");
            xb_add(&bar[XB_XGEN(b.x)], 1u);
            asm volatile("s_waitcnt vmcnt(0)" ::: "memory");
        } else {
            XB_SPIN(xb_ld(&bar[XB_XGEN(b.x)]) == gen, bar);
            __builtin_amdgcn_fence(__ATOMIC_ACQUIRE, "agent");
            asm volatile("s_waitcnt vmcnt(0)" ::: "memory");
        }
    }
    __syncthreads();
}

template <bool DUAL, bool ABF16, class Epi>
__device__ __forceinline__ void sgemm_unit(const int tid, LAS float* sm, const void* arow, const float* B, const float* B2, int ldb, int n0, int Nlim, int K, const Epi& epi) {
    LAS float* As = sm; LAS float* Bs = sm + 16 * 132; LAS float* B2s = Bs + 16 * 128;
    const int ar = tid >> 2, ak = (tid & 3) * 4, bk = tid >> 5, bn = (tid & 31) * 4, ty = tid >> 4, tx = tid & 15;
    const bool bvalid = (n0 + bn) < Nlim;
    float acc[4][8], acc2[4][8];
#pragma unroll
    for (int i = 0; i < 4; ++i)
#pragma unroll
        for (int j = 0; j < 8; ++j) { acc[i][j] = 0.f; acc2[i][j] = 0.f; }
    float4 ra, rb, rb2; rb2 = make_float4(0.f, 0.f, 0.f, 0.f);
#define SG_LOAD(k0) do { \
        if (ABF16) { const uint2 t_ = *(const uint2*)((const bf16_t*)arow + (k0) + ak); ra.x = bflo(t_.x); ra.y = bfhi(t_.x); ra.z = bflo(t_.y); ra.w = bfhi(t_.y); } \
        else { ra = *(const float4*)((const float*)arow + (k0) + ak); } \
        rb = bvalid ? *(const float4*)(B + (size_t)((k0) + bk) * ldb + n0 + bn) : make_float4(0.f, 0.f, 0.f, 0.f); \
        if (DUAL) rb2 = bvalid ? *(const float4*)(B2 + (size_t)((k0) + bk) * ldb + n0 + bn) : make_float4(0.f, 0.f, 0.f, 0.f); } while (0)
    SG_LOAD(0);
    for (int k0 = 0; k0 < K; k0 += 16) {
        As[(ak + 0) * 132 + ar] = ra.x; As[(ak + 1) * 132 + ar] = ra.y; As[(ak + 2) * 132 + ar] = ra.z; As[(ak + 3) * 132 + ar] = ra.w;
        *(LAS f32x4*)(Bs + bk * 128 + bn) = (f32x4){rb.x, rb.y, rb.z, rb.w};
        if (DUAL) *(LAS f32x4*)(B2s + bk * 128 + bn) = (f32x4){rb2.x, rb2.y, rb2.z, rb2.w};
        __syncthreads();
        if (k0 + 16 < K) SG_LOAD(k0 + 16);
#pragma unroll 2
        for (int k = 0; k < 16; ++k) {
            const f32x4 a = *(const LAS f32x4*)(As + k * 132 + ty * 4);
            const f32x4 b0 = *(const LAS f32x4*)(Bs + k * 128 + tx * 8), b1 = *(const LAS f32x4*)(Bs + k * 128 + tx * 8 + 4);
            const float av[4] = {a.x, a.y, a.z, a.w}; const float bv[8] = {b0.x, b0.y, b0.z, b0.w, b1.x, b1.y, b1.z, b1.w};
#pragma unroll
            for (int i = 0; i < 4; ++i)
#pragma unroll
                for (int j = 0; j < 8; ++j) acc[i][j] = fmaf(av[i], bv[j], acc[i][j]);
            if (DUAL) {
                const f32x4 c0 = *(const LAS f32x4*)(B2s + k * 128 + tx * 8), c1 = *(const LAS f32x4*)(B2s + k * 128 + tx * 8 + 4);
                const float cv[8] = {c0.x, c0.y, c0.z, c0.w, c1.x, c1.y, c1.z, c1.w};
#pragma unroll
                for (int i = 0; i < 4; ++i)
#pragma unroll
                    for (int j = 0; j < 8; ++j) acc2[i][j] = fmaf(av[i], cv[j], acc2[i][j]);
            }
        }
        __syncthreads();
    }
#undef SG_LOAD
#pragma unroll
    for (int i = 0; i < 4; ++i) epi(ty * 4 + i, tx * 8, acc[i], acc2[i]);
}

__device__ __forceinline__ void store8_bf16(bf16_t* p, const float (&v)[8]) {
    uint4 o; o.x = pk2(v[0], v[1]); o.y = pk2(v[2], v[3]); o.z = pk2(v[4], v[5]); o.w = pk2(v[6], v[7]);
    *(uint4*)p = o;
}


namespace g8 {
typedef short bf16x8 __attribute__((ext_vector_type(8)));
typedef unsigned u32x4 __attribute__((ext_vector_type(4)));
typedef unsigned u32x2 __attribute__((ext_vector_type(2)));
constexpr int BM = 256, BK = 64, HALF = 128, HTB = HALF * BK * 2, STAGE_BYTES = 8 * HTB, NXCD = 8, WGM = 8;
__device__ __forceinline__ int lds_byte(int r, int c) { const int st = (r >> 4) * 2 + (c >> 5), rr = r & 15, cc = c & 31, ob = rr * 64 + cc * 2; return st * 1024 + (ob ^ (((ob >> 9) & 1) << 5)); }
__device__ __forceinline__ void stage_rc(int b, int& R, int& C) { const int st = b / 1024, sb = b % 1024, swz = sb ^ (((sb >> 9) & 1) << 5); R = (st >> 1) * 16 + swz / 64; C = (st & 1) * 32 + (swz % 64) / 2; }
__device__ __forceinline__ int perm32(int rho) { const int n = rho >> 4, i = rho & 15; return 8 * (i >> 2) + 4 * n + (i & 3); }
__device__ __forceinline__ unsigned cvt_pk_bf16(float lo, float hi) { unsigned r; asm volatile("v_cvt_pk_bf16_f32 %0, %1, %2" : "=v"(r) : "v"(lo), "v"(hi)); return r; }

struct Unit { unsigned ao, bo; int lidx, m0, n0, nvalid, kind; };

__device__ __forceinline__ int xcd_remap(int L, int nwg) { const int q = nwg / NXCD, r = nwg % NXCD, xcd = L % NXCD, off = L / NXCD; return (xcd < r ? xcd * (q + 1) : r * (q + 1) + (xcd - r) * q) + off; }
__device__ __forceinline__ void order_decode(int wgid, int nM, int nN, int& pm, int& pn) {
    const int nig = WGM * nN, gid = wgid / nig, fm = gid * WGM, gsz = (nM - fm) < WGM ? (nM - fm) : WGM;
    pm = fm + ((wgid % nig) % gsz); pn = (wgid % nig) / gsz;
}
struct DenseSched {
    static constexpr bool GATHER = false; const char* Abase; const char* Bbase; const int* list; int nM, nN, K, G, c;
    __device__ __forceinline__ bool next(int i, Unit& u) const {
        const int nwg = nM * nN; const int L = i * G + c; if (L >= nwg) return false;
        int pm, pn; order_decode(xcd_remap(L, nwg), nM, nN, pm, pn);
        u.ao = (unsigned)pm * 256u * (unsigned)K * 2u; u.bo = (unsigned)pn * 256u * (unsigned)K * 2u; u.lidx = -1; u.m0 = pm * 256; u.n0 = pn * 256; u.nvalid = 256; u.kind = 0; return true;
    }
};
struct MoeSched {
    static constexpr bool GATHER = true; int vt, vr, vcn; int NTR, nN1; const char* Abase; const char* Bbase; unsigned b1off, bstride; const int* list;
    int nM2, nN2; unsigned b2off; int K, G, c;
    __device__ __forceinline__ bool next(int i, Unit& u) const {
        const int NT1 = NTR + T / 256, U1 = NT1 * nN1, U2 = nM2 * nN2; const int L = i * G + c;
        const int x = L % NXCD, off = L / NXCD, q1 = U1 / NXCD, r1 = U1 % NXCD, q2 = U2 / NXCD, r2 = U2 % NXCD;
        const int n1 = q1 + (x < r1 ? 1 : 0), n2 = q2 + (x < r2 ? 1 : 0); if (off >= n1 + n2) return false;
        const bool blk1 = off < n1;
        const int w = blk1 ? x * q1 + (x < r1 ? x : r1) + off : x * q2 + (x < r2 ? x : r2) + (off - n1);
        int pm, pn; order_decode(w, blk1 ? NT1 : nM2, blk1 ? nN1 : nN2, pm, pn);
        pm = __builtin_amdgcn_readfirstlane(pm); pn = __builtin_amdgcn_readfirstlane(pn);
        const bool routed = blk1 && pm < NTR;
        const int pmr = routed ? pm : 0;
        const int e = __builtin_popcountll(__ballot(vt <= pmr)) - 1; const int te = __builtin_amdgcn_readlane(vt, e), ce = __builtin_amdgcn_readlane(vcn, e), re = __builtin_amdgcn_readlane(vr, e);
        const int ti = routed ? pm - te : (blk1 ? pm - NTR : pm);
        const int nv = ce - ti * 256;
        const int m0 = routed ? re + ti * 256 : (blk1 ? T * TOPK + ti * 256 : ti * 256);
        const bool gather = routed && list != nullptr;
        const unsigned arow = gather ? 0u : ((blk1 && list == nullptr) ? (unsigned)m0 : (unsigned)ti * 256u);
        u.ao = arow * (unsigned)K * 2u; u.bo = (blk1 ? b1off + (unsigned)(routed ? e : 64) * bstride : b2off) + (unsigned)pn * 256u * (unsigned)K * 2u;
        u.lidx = gather ? e * T + ti * 256 : -1; u.m0 = m0; u.n0 = pn * 256; u.nvalid = routed ? (nv < 256 ? nv : 256) : 256; u.kind = routed ? 1 : (blk1 ? 2 : 3);
        return true;
    }
};

typedef int i32x8 __attribute__((ext_vector_type(8)));
typedef int i32x4 __attribute__((ext_vector_type(4)));
__device__ __forceinline__ i32x8 cat8(bf16x8 a, bf16x8 b) { const i32x4 x = __builtin_bit_cast(i32x4, a), y = __builtin_bit_cast(i32x4, b); return __builtin_shufflevector(x, y, 0, 1, 2, 3, 4, 5, 6, 7); }
template <class Epi, class Sched, bool F8 = false>
__device__ __forceinline__ void gemm_phase(const int tid, LAS unsigned char* lds, const int K, const Sched& S, const Epi& E) {
    const int wid = __builtin_amdgcn_readfirstlane(tid >> 6), lane = tid & 63, wr = wid >> 2, wc = wid & 3, fr = lane & 15, fq = lane >> 4;
    const int nt = K / BK;
    unsigned voffB[2];
#pragma unroll
    for (int i = 0; i < 2; ++i) { int R, C; stage_rc(tid * 16 + i * 8192, R, C);
        const int Rb = Epi::PERM2 ? 64 * (R >> 5) + 16 * ((R >> 2) & 3) + 4 * ((R >> 4) & 1) + (R & 3) : (R & ~31) + perm32(R & 31); voffB[i] = (unsigned)(Rb * K + C) * 2u; }
    const unsigned kstep = (unsigned)(BK * 2);
    const unsigned hstep = (Epi::PERM2 ? 8u : (unsigned)HALF) * (unsigned)K * 2u;
    const unsigned ldsw = (unsigned)wid * 1024u;
    const int aoff = lds_byte(wr * 64 + fr, fq * 8), boff = lds_byte(wc * 32 + fr, fq * 8);
    const char* const Ab = S.Abase; const char* const Bb = S.Bbase;
#define G8_SA(b, h) (((b) * 2 + (h)) * HTB)
#define G8_SB(b, h) ((4 + (b) * 2 + (h)) * HTB)
#define G8_STAGE(bufoff, gbase, soff, voff) do { _Pragma("unroll") for (int _i = 0; _i < 2; ++_i) \
        __builtin_amdgcn_global_load_lds((const unsigned*)((gbase) + (size_t)(soff) + (voff)[_i]), (LAS unsigned*)(lds + (bufoff) + ldsw + _i * 8192), 16, 0, 0); } while (0)
#define G8_LDA(dst, b, h) do { _Pragma("unroll") for (int m = 0; m < 4; ++m) _Pragma("unroll") for (int k = 0; k < 2; ++k) dst[m][k] = *(const LAS bf16x8*)(lds + G8_SA(b, h) + aoff + m * 2048 + k * 1024); } while (0)
#define G8_LDB(dst, b, h) do { _Pragma("unroll") for (int n = 0; n < 2; ++n) _Pragma("unroll") for (int k = 0; k < 2; ++k) dst[n][k] = *(const LAS bf16x8*)(lds + G8_SB(b, h) + boff + n * 2048 + k * 1024); } while (0)
#define G8_MMA(ai, bj, At, Bt) do { __builtin_amdgcn_s_setprio(1); _Pragma("unroll") for (int m = 0; m < 4; ++m) _Pragma("unroll") for (int n = 0; n < 2; ++n) { \
        if constexpr (F8) acc[ai][bj][m][n] = __builtin_amdgcn_mfma_scale_f32_16x16x128_f8f6f4(cat8(Bt[n][0], Bt[n][1]), cat8(At[m][0], At[m][1]), acc[ai][bj][m][n], 0, 0, 0, Epi::SC8, 0, Epi::SC8); \
        else { _Pragma("unroll") for (int k = 0; k < 2; ++k) acc[ai][bj][m][n] = __builtin_amdgcn_mfma_f32_16x16x32_bf16(Bt[n][k], At[m][k], acc[ai][bj][m][n], 0, 0, 0); } } \
        __builtin_amdgcn_s_setprio(0); } while (0)
#define G8_WAIT_V(n) asm volatile("s_waitcnt vmcnt(" #n ")" ::: "memory")
#define G8_WAIT_L(n) asm volatile("s_waitcnt lgkmcnt(" #n ")" ::: "memory")
#define G8_BAR __builtin_amdgcn_s_barrier()
#define G8_SCHED __builtin_amdgcn_sched_barrier(0)
#define G8_LOADV(dst, u) do { int R0_, C0_, R1_, C1_; stage_rc(tid * 16, R0_, C0_); stage_rc(tid * 16 + 8192, R1_, C1_); \
        if ((u).lidx >= 0) { const int* lp_ = S.list + (u).lidx; const int nv_ = (u).nvalid - 1; \
            const int i00 = lp_[R0_ < nv_ ? R0_ : nv_], i01 = lp_[R1_ < nv_ ? R1_ : nv_], i10 = lp_[R0_ + 128 < nv_ ? R0_ + 128 : nv_], i11 = lp_[R1_ + 128 < nv_ ? R1_ + 128 : nv_]; \
            dst[0][0] = ((unsigned)i00 * (unsigned)K + (unsigned)C0_) * 2u; dst[0][1] = ((unsigned)i01 * (unsigned)K + (unsigned)C1_) * 2u; \
            dst[1][0] = ((unsigned)i10 * (unsigned)K + (unsigned)C0_) * 2u; dst[1][1] = ((unsigned)i11 * (unsigned)K + (unsigned)C1_) * 2u; } \
        else { dst[0][0] = ((unsigned)R0_ * (unsigned)K + (unsigned)C0_) * 2u; dst[0][1] = ((unsigned)R1_ * (unsigned)K + (unsigned)C1_) * 2u; \
            dst[1][0] = ((unsigned)(R0_ + 128) * (unsigned)K + (unsigned)C0_) * 2u; dst[1][1] = ((unsigned)(R1_ + 128) * (unsigned)K + (unsigned)C1_) * 2u; } } while (0)
    Unit cur, nxt; int ui = 0;
    if (!S.next(0, cur)) return;
    f32x4 acc[2][2][4][2];
#pragma unroll
    for (int a = 0; a < 2; ++a)
#pragma unroll
        for (int b = 0; b < 2; ++b)
#pragma unroll
            for (int m = 0; m < 4; ++m)
#pragma unroll
                for (int n = 0; n < 2; ++n) acc[a][b][m][n] = (f32x4){0.f, 0.f, 0.f, 0.f};
    bf16x8 At[4][2], B0[2][2], B1[2][2];
    unsigned vc[2][2], vn[2][2];
    G8_LOADV(vc, cur);
    unsigned cA = cur.ao, cB = cur.bo;
    G8_STAGE(G8_SB(0, 0), Bb, cB, voffB); G8_STAGE(G8_SB(0, 1), Bb, cB + hstep, voffB); G8_STAGE(G8_SA(0, 0), Ab, cA, vc[0]); G8_STAGE(G8_SA(0, 1), Ab, cA, vc[1]);
    if (wr == 1) G8_BAR;
    G8_WAIT_V(2); G8_BAR;
    G8_STAGE(G8_SB(1, 0), Bb, cB + kstep, voffB); G8_STAGE(G8_SA(1, 0), Ab, cA + kstep, vc[0]); G8_STAGE(G8_SB(1, 1), Bb, cB + hstep + kstep, voffB);
    G8_WAIT_V(6); G8_BAR;
    for (;;) {
        const bool has_next = S.next(ui + 1, nxt);
        const unsigned nA = has_next ? nxt.ao : cA, nB = has_next ? nxt.bo : cB;
        if constexpr (Sched::GATHER) { if (has_next) { G8_LOADV(vn, nxt); } else {
#pragma unroll
            for (int h = 0; h < 2; ++h)
#pragma unroll
                for (int i = 0; i < 2; ++i) vn[h][i] = vc[h][i]; } }
#pragma unroll 1
        for (int t = 0; t < nt; t += 2) {
            const bool last = (t == nt - 2);
            unsigned tk = (unsigned)t * kstep; asm volatile("" : "+s"(tk));
            const unsigned a1 = cA + tk + kstep;
            const unsigned a2 = last ? nA : cA + tk + 2 * kstep, b2 = last ? nB : cB + tk + 2 * kstep;
            const unsigned a3 = a2 + kstep, b3 = b2 + kstep;
            if constexpr (Epi::MIDK) { if (t == nt / 2) E.midk(acc, cur, wr, wc, fr, fq); }
            G8_LDB(B0, 0, 0); G8_LDB(B1, 0, 1); G8_SCHED; G8_LDA(At, 0, 0); G8_STAGE(G8_SA(1, 1), Ab, a1, vc[1]);
            if constexpr (Sched::GATHER) { if (last) { _Pragma("unroll") for (int h = 0; h < 2; ++h) _Pragma("unroll") for (int i = 0; i < 2; ++i) vc[h][i] = vn[h][i]; } }
            G8_WAIT_V(8); G8_WAIT_L(0); G8_BAR; G8_MMA(0, 0, At, B0); G8_MMA(0, 1, At, B1); G8_BAR; G8_SCHED;
            G8_LDA(At, 0, 1); G8_STAGE(G8_SB(0, 0), Bb, b2, voffB); G8_STAGE(G8_SB(0, 1), Bb, b2 + hstep, voffB); G8_STAGE(G8_SA(0, 0), Ab, a2, vc[0]);
            G8_WAIT_V(8); G8_WAIT_L(0); G8_BAR; G8_MMA(1, 0, At, B0); G8_MMA(1, 1, At, B1); G8_BAR; G8_SCHED;
            G8_LDB(B0, 1, 0); G8_LDB(B1, 1, 1); G8_SCHED; G8_LDA(At, 1, 0); G8_STAGE(G8_SA(0, 1), Ab, a2, vc[1]);
            G8_WAIT_V(8); G8_WAIT_L(0); G8_BAR; G8_MMA(0, 0, At, B0); G8_MMA(0, 1, At, B1); G8_BAR; G8_SCHED;
            G8_LDA(At, 1, 1); G8_STAGE(G8_SB(1, 0), Bb, b3, voffB); G8_STAGE(G8_SB(1, 1), Bb, b3 + hstep, voffB); G8_STAGE(G8_SA(1, 0), Ab, a3, vc[0]);
            G8_WAIT_V(8); G8_WAIT_L(0); G8_BAR; G8_MMA(1, 0, At, B0); G8_MMA(1, 1, At, B1); G8_BAR; G8_SCHED;
        }
        if (wr == 0) G8_BAR;
        E(acc, cur, wr, wc, fr, fq);
        if (!has_next) break;
#pragma unroll
        for (int a = 0; a < 2; ++a)
#pragma unroll
            for (int b = 0; b < 2; ++b)
#pragma unroll
                for (int m = 0; m < 4; ++m)
#pragma unroll
                    for (int n = 0; n < 2; ++n) acc[a][b][m][n] = (f32x4){0.f, 0.f, 0.f, 0.f};
        cur = nxt; cA = nA; cB = nB; ++ui;
        if (wr == 1) G8_BAR;
    }
    G8_WAIT_V(0);
    G8_BAR;
#undef G8_SA
#undef G8_SB
#undef G8_STAGE
#undef G8_LDA
#undef G8_LDB
#undef G8_MMA
#undef G8_WAIT_V
#undef G8_WAIT_L
#undef G8_BAR
#undef G8_SCHED
#undef G8_LOADV
}

__device__ __forceinline__ float fast_sigmoid(float x) { return __builtin_amdgcn_rcpf(1.0f + __expf(-x)); }
__device__ __forceinline__ float gelu_tanh_fast(float x) { return x * fast_sigmoid(1.5957691216057308f * (x + 0.044715f * x * x * x)); }

struct EpiZ {
    static constexpr int SC8 = 0x7C7C7C7C; static constexpr bool MIDK = false, PERM2 = false; bf16_t* Zp; int coff; unsigned* nrm;
    __device__ __forceinline__ void operator()(const f32x4 (&acc)[2][2][4][2], const Unit& u, int wr, int wc, int fr, int fq) const {
        const int c0 = coff + u.n0; const bool act = (c0 >= OFF_GMLP && c0 < OFF_Q);
#pragma unroll
        for (int ai = 0; ai < 2; ++ai)
#pragma unroll
            for (int m = 0; m < 4; ++m) { bf16_t* rowp = Zp + (size_t)(u.m0 + ai * HALF + wr * 64 + m * 16 + fr) * ZW + c0 + wc * 32 + 8 * fq;
#pragma unroll
                for (int bj = 0; bj < 2; ++bj) { f32x4 v0 = acc[ai][bj][m][0], v1 = acc[ai][bj][m][1];
                    if (act) {
#pragma unroll
                        for (int j = 0; j < 4; ++j) { v0[j] = gelu_tanh_fast(v0[j]); v1[j] = gelu_tanh_fast(v1[j]); } }
                    u32x4 w; w.x = cvt_pk_bf16(v0[0], v0[1]); w.y = cvt_pk_bf16(v0[2], v0[3]); w.z = cvt_pk_bf16(v1[0], v1[1]); w.w = cvt_pk_bf16(v1[2], v1[3]);
                    *(u32x4*)(rowp + bj * HALF) = w; } }
        if (nrm != nullptr && c0 >= OFF_Q && c0 < OFF_V) {
            float mx0 = 0.f, mx1 = 0.f;
#pragma unroll
            for (int ai = 0; ai < 2; ++ai)
#pragma unroll
                for (int m = 0; m < 4; ++m)
#pragma unroll
                    for (int bj = 0; bj < 2; ++bj) { const f32x4 v0 = acc[ai][bj][m][0], v1 = acc[ai][bj][m][1];
                        float ss = (v0[0] * v0[0] + v0[1] * v0[1]) + (v0[2] * v0[2] + v0[3] * v0[3]) + (v1[0] * v1[0] + v1[1] * v1[1]) + (v1[2] * v1[2] + v1[3] * v1[3]);
                        ss += swz_xor<16>(ss); { const auto rr = __builtin_amdgcn_permlane32_swap(__float_as_uint(ss), __float_as_uint(ss), false, false); ss = __uint_as_float(rr[0]) + __uint_as_float(rr[1]); }
                        if (bj == 0) mx0 = fmaxf(mx0, ss); else mx1 = fmaxf(mx1, ss); }
            mx0 = fmaxf(mx0, swz_xor<1>(mx0)); mx0 = fmaxf(mx0, swz_xor<2>(mx0)); mx0 = fmaxf(mx0, swz_xor<4>(mx0)); mx0 = fmaxf(mx0, swz_xor<8>(mx0));
            mx1 = fmaxf(mx1, swz_xor<1>(mx1)); mx1 = fmaxf(mx1, swz_xor<2>(mx1)); mx1 = fmaxf(mx1, swz_xor<4>(mx1)); mx1 = fmaxf(mx1, swz_xor<8>(mx1));
            if (fr == 0 && fq == 0) { const int sel = c0 >= OFF_K ? 1 : 0, bb = u.m0 / S, h0 = (c0 & 1023) >> 7; unsigned* np = nrm + ((sel * 64 + bb * 8 + h0) * 4 + wc);
                atomicMax(np, __float_as_uint(mx0)); atomicMax(np + 4, __float_as_uint(mx1)); }
        }
    }
};
struct EpiBf {
    static constexpr bool MIDK = false, PERM2 = false; bf16_t* O; int ldc;
    __device__ __forceinline__ void operator()(const f32x4 (&acc)[2][2][4][2], const Unit& u, int wr, int wc, int fr, int fq) const {
#pragma unroll
        for (int ai = 0; ai < 2; ++ai)
#pragma unroll
            for (int m = 0; m < 4; ++m) { bf16_t* rowp = O + (size_t)(u.m0 + ai * HALF + wr * 64 + m * 16 + fr) * ldc + u.n0 + wc * 32 + 8 * fq;
#pragma unroll
                for (int bj = 0; bj < 2; ++bj) { const f32x4 v0 = acc[ai][bj][m][0], v1 = acc[ai][bj][m][1];
                    u32x4 w; w.x = cvt_pk_bf16(v0[0], v0[1]); w.y = cvt_pk_bf16(v0[2], v0[3]); w.z = cvt_pk_bf16(v1[0], v1[1]); w.w = cvt_pk_bf16(v1[2], v1[3]);
                    *(u32x4*)(rowp + bj * HALF) = w; } }
    }
};
struct EpiU1 {
    static constexpr bool MIDK = true, PERM2 = false; const bf16_t* X; float* U; const float* ssq;
    __device__ __forceinline__ void midk(f32x4 (&acc)[2][2][4][2], const Unit& u, int wr, int wc, int fr, int fq) const {
#pragma unroll
        for (int ai = 0; ai < 2; ++ai)
#pragma unroll
            for (int m = 0; m < 4; ++m) { const float* sp = ssq + (size_t)(u.m0 + ai * HALF + wr * 64 + m * 16 + fr) * 8; const f32x4 s0 = *(const f32x4*)sp, s1 = *(const f32x4*)(sp + 4);
                const float rc = rsqrtf(((s0[0] + s0[1]) + (s0[2] + s0[3]) + (s1[0] + s1[1]) + (s1[2] + s1[3])) * (1.f / 1024.f) + LN_EPS);
#pragma unroll
                for (int bj = 0; bj < 2; ++bj)
#pragma unroll
                    for (int n = 0; n < 2; ++n) acc[ai][bj][m][n] *= rc;
                if (m & 1) asm volatile("" ::: "memory"); }
    }
    __device__ __forceinline__ void operator()(const f32x4 (&acc)[2][2][4][2], const Unit& u, int wr, int wc, int fr, int fq) const {
        u32x4 xs[2][4][2];
#pragma unroll
        for (int ai = 0; ai < 2; ++ai)
#pragma unroll
            for (int m = 0; m < 4; ++m) { const size_t o = (size_t)(u.m0 + ai * HALF + wr * 64 + m * 16 + fr) * D + u.n0 + wc * 32 + 8 * fq;
#pragma unroll
                for (int bj = 0; bj < 2; ++bj) xs[ai][m][bj] = *(const u32x4*)(X + o + bj * HALF); }
        asm volatile("" ::: "memory");
#pragma unroll
        for (int ai = 0; ai < 2; ++ai)
#pragma unroll
            for (int m = 0; m < 4; ++m) { const size_t o = (size_t)(u.m0 + ai * HALF + wr * 64 + m * 16 + fr) * D + u.n0 + wc * 32 + 8 * fq;
#pragma unroll
                for (int bj = 0; bj < 2; ++bj) { const u32x4 xv = xs[ai][m][bj]; const f32x4 v0 = acc[ai][bj][m][0], v1 = acc[ai][bj][m][1];
                    f32x4 o0, o1; o0[0] = fmaf(ALPHA, bflo(xv.x), v0[0]); o0[1] = fmaf(ALPHA, bfhi(xv.x), v0[1]); o0[2] = fmaf(ALPHA, bflo(xv.y), v0[2]); o0[3] = fmaf(ALPHA, bfhi(xv.y), v0[3]);
                    o1[0] = fmaf(ALPHA, bflo(xv.z), v1[0]); o1[1] = fmaf(ALPHA, bfhi(xv.z), v1[1]); o1[2] = fmaf(ALPHA, bflo(xv.w), v1[2]); o1[3] = fmaf(ALPHA, bfhi(xv.w), v1[3]);
                    u32x4 w; w.x = cvt_pk_bf16(o0[0], o0[1]); w.y = cvt_pk_bf16(o0[2], o0[3]); w.z = cvt_pk_bf16(o1[0], o1[1]); w.w = cvt_pk_bf16(o1[2], o1[3]);
                    *(u32x4*)((bf16_t*)U + o + bj * HALF) = w; } }
    }
};
struct EpiUp {
    static constexpr int SC8 = USE_FP8 ? 0x7C7C7C7C : 0x7F7F7F7F;     static constexpr bool MIDK = false, PERM2 = false; void* Hp; const bf16_t* X; const bf16_t* PEp; const float* bpg; bf16_t* B16; float osc; bool h8;
    __device__ __forceinline__ void operator()(const f32x4 (&acc)[2][2][4][2], const Unit& u, int wr, int wc, int fr, int fq) const {
        if (u.kind != 3) {
#pragma unroll
            for (int ai = 0; ai < 2; ++ai)
#pragma unroll
                for (int m = 0; m < 4; ++m) { const int rl = ai * HALF + wr * 64 + m * 16 + fr;
                    if (rl < u.nvalid) { const size_t eo = (size_t)(u.m0 + rl) * DE + (u.n0 >> 1) + wc * 16 + 4 * fq;
#pragma unroll
                        for (int bj = 0; bj < 2; ++bj) { f32x4 a = acc[ai][bj][m][0], b = acc[ai][bj][m][1]; if (!USE_FP8) { a *= osc; b *= osc; } float hv[4];
#pragma unroll
                            for (int j = 0; j < 4; ++j) hv[j] = a[j] * fast_sigmoid(a[j]) * b[j];
                            if (h8) *(unsigned*)((unsigned char*)Hp + eo + bj * 64) = pk4_fp8(hv[0], hv[1], hv[2], hv[3]);
                            else { u32x2 w; w.x = cvt_pk_bf16(hv[0], hv[1]); w.y = cvt_pk_bf16(hv[2], hv[3]); *(u32x2*)((bf16_t*)Hp + eo + bj * 64) = w; } } } }
        } else {
            f32x4 gb[2][2];
#pragma unroll
            for (int bj = 0; bj < 2; ++bj) { gb[bj][0] = *(const f32x4*)(bpg + u.n0 + wc * 32 + 8 * fq + bj * HALF); gb[bj][1] = *(const f32x4*)(bpg + u.n0 + wc * 32 + 8 * fq + bj * HALF + 4); }
#pragma unroll
            for (int ai = 0; ai < 2; ++ai) {
                u32x4 xs[4][2], ps[4][2];
#pragma unroll
                for (int m = 0; m < 4; ++m) { const size_t o = (size_t)(u.m0 + ai * HALF + wr * 64 + m * 16 + fr) * D + u.n0 + wc * 32 + 8 * fq;
#pragma unroll
                    for (int bj = 0; bj < 2; ++bj) { xs[m][bj] = *(const u32x4*)(X + o + bj * HALF); ps[m][bj] = *(const u32x4*)(PEp + o + bj * HALF); } }
                asm volatile("" ::: "memory");
#pragma unroll
                for (int m = 0; m < 4; ++m) { const size_t o = (size_t)(u.m0 + ai * HALF + wr * 64 + m * 16 + fr) * D + u.n0 + wc * 32 + 8 * fq;
#pragma unroll
                    for (int bj = 0; bj < 2; ++bj) { const u32x4 xv = xs[m][bj], pv = ps[m][bj];
                        const f32x4 v0 = (USE_FP8 ? acc[ai][bj][m][0] : acc[ai][bj][m][0] * osc) + gb[bj][0], v1 = (USE_FP8 ? acc[ai][bj][m][1] : acc[ai][bj][m][1] * osc) + gb[bj][1]; f32x4 o0, o1;
                        o0[0] = fmaf(ALPHA, bflo(xv.x), fast_sigmoid(v0[0]) * bflo(pv.x)); o0[1] = fmaf(ALPHA, bfhi(xv.x), fast_sigmoid(v0[1]) * bfhi(pv.x));
                        o0[2] = fmaf(ALPHA, bflo(xv.y), fast_sigmoid(v0[2]) * bflo(pv.y)); o0[3] = fmaf(ALPHA, bfhi(xv.y), fast_sigmoid(v0[3]) * bfhi(pv.y));
                        o1[0] = fmaf(ALPHA, bflo(xv.z), fast_sigmoid(v1[0]) * bflo(pv.z)); o1[1] = fmaf(ALPHA, bfhi(xv.z), fast_sigmoid(v1[1]) * bfhi(pv.z));
                        o1[2] = fmaf(ALPHA, bflo(xv.w), fast_sigmoid(v1[2]) * bflo(pv.w)); o1[3] = fmaf(ALPHA, bfhi(xv.w), fast_sigmoid(v1[3]) * bfhi(pv.w));
                        u32x4 w; w.x = cvt_pk_bf16(o0[0], o0[1]); w.y = cvt_pk_bf16(o0[2], o0[3]); w.z = cvt_pk_bf16(o1[0], o1[1]); w.w = cvt_pk_bf16(o1[2], o1[3]);
                        *(u32x4*)(B16 + o + bj * HALF) = w; } }
                asm volatile("" ::: "memory"); }
        }
    }
};
struct EpiDown {
    static constexpr int SC8 = USE_FP8 ? 0x7E7E7E7E : 0x7F7F7F7F;     static constexpr bool MIDK = false, PERM2 = true; unsigned char* Y2p; unsigned char* YSp; float osc;
    __device__ __forceinline__ void operator()(const f32x4 (&acc)[2][2][4][2], const Unit& u, int wr, int wc, int fr, int fq) const {
        const float sc = osc * Y2_SCALE;
        unsigned char* const base = u.kind == 1 ? Y2p + (size_t)u.m0 * D : YSp + (size_t)(u.m0 - T * TOPK) * (2 * D);
        const unsigned rstride = u.kind == 1 ? (unsigned)D : (unsigned)(2 * D);
        const unsigned off0 = (unsigned)(wr * 64 + fr) * rstride + (unsigned)(u.n0 + wc * 64 + 16 * fq);
#pragma unroll
        for (int ai = 0; ai < 2; ++ai)
#pragma unroll
            for (int m = 0; m < 4; ++m) { const int rl = ai * HALF + wr * 64 + m * 16 + fr;
                if (rl < u.nvalid) {
                    f32x4 a0 = acc[ai][0][m][0], a1 = acc[ai][0][m][1], b0 = acc[ai][1][m][0], b1 = acc[ai][1][m][1];
                    if (!USE_FP8) { a0 *= sc; a1 *= sc; b0 *= sc; b1 *= sc; }
                    u32x4 w; w.x = pk4_fp8(a0[0], a0[1], a0[2], a0[3]); w.y = pk4_fp8(a1[0], a1[1], a1[2], a1[3]); w.z = pk4_fp8(b0[0], b0[1], b0[2], b0[3]); w.w = pk4_fp8(b1[0], b1[1], b1[2], b1[3]);
                    *(u32x4*)(base + (off0 + (unsigned)(ai * HALF + m * 16) * rstride)) = w; } }
    }
};
}


namespace att {
typedef short bf16x8 __attribute__((ext_vector_type(8)));
typedef short s16x4 __attribute__((ext_vector_type(4)));
typedef float f32x16 __attribute__((ext_vector_type(16)));
typedef unsigned u32x4 __attribute__((ext_vector_type(4)));
constexpr int DH = 128, NW = 8, QBLK = 32, KVBLK = 64, QB = NW * QBLK, NQB = S / QB;
constexpr int SHM_V = KVBLK * DH * 2, SHM_K = KVBLK * DH * 2;
constexpr int LDS_ATT = 2 * SHM_V + 2 * SHM_K + NW * 64 * 4;
constexpr int LDS_C = LDS_ATT;
constexpr float SCALE = 0.08838834764831845f, THR = 8.f, INV_SCALE = 11.313708498984761f;
constexpr int QKV_LD = ZW, O_LD = D;
#define KSWZ(row, colB) ((row) * 256 + ((colB) ^ (((row) & 7) << 4)))
#define SBAR() __builtin_amdgcn_sched_barrier(0)
__device__ __forceinline__ int v_st(int k, int c) { const int kk = (k & ~0xC) | ((k & 4) << 1) | ((k & 8) >> 1); return ((kk >> 3) * 4 + (c >> 5)) * 512 + ((kk & 7) * 32 + (c & 31)) * 2; }
__device__ __forceinline__ int v_rd_base(int lane) { return ((lane & 3) << 3) | (((lane >> 2) & 3) << 6) | (((lane >> 4) & 1) << 5) | (((lane >> 5) & 1) << 8); }
constexpr int v_rd_off(int d0, int ks, int half) { return d0 * 512 + ks * 4096 + half * 2048; }
__device__ __forceinline__ int crow(int r, int hi) { return (r & 3) + 8 * (r >> 2) + 4 * hi; }
__device__ __forceinline__ unsigned cvtpk(float lo, float hi) { unsigned r; asm volatile("v_cvt_pk_bf16_f32 %0, %1, %2" : "=v"(r) : "v"(lo), "v"(hi)); return r; }
__device__ __forceinline__ bf16x8 load8(const bf16_t* p) { return *reinterpret_cast<const bf16x8*>(p); }
__device__ __forceinline__ void mask_tile(f32x16& p0, f32x16& p1, int dq) {
    const float NEG = -__builtin_inff();
#pragma unroll
    for (int r = 0; r < 16; ++r) {
        const int c = (r & 3) + 8 * (r >> 2);
        if (dq - c < 0) p0[r] = NEG;
        if (dq - c - 32 < 0) p1[r] = NEG;
    }
}
__device__ __forceinline__ void partialSM(f32x16& p0, f32x16& p1, float& m_reg, float& mn, float& alpha) {
    float pmax = p0[0]; for (int r = 1; r < 16; ++r) pmax = fmaxf(pmax, p0[r]); for (int r = 0; r < 16; ++r) pmax = fmaxf(pmax, p1[r]);
    { auto rr = __builtin_amdgcn_permlane32_swap(__float_as_uint(pmax), __float_as_uint(pmax), false, false);
      pmax = fmaxf(__uint_as_float(rr[0]), __uint_as_float(rr[1])); }
    constexpr float C2 = 1.4426950408889634f * SCALE;
    if (__builtin_expect(__all((pmax - m_reg) * SCALE <= THR), 1)) { mn = m_reg; alpha = 1.f; }
    else { mn = fmaxf(m_reg, pmax); alpha = __builtin_amdgcn_exp2f((m_reg - mn) * C2); m_reg = mn; }
    const float mnL = -mn * C2;
    for (int r = 0; r < 16; ++r) p0[r] = fmaf(p0[r], C2, mnL); for (int r = 0; r < 16; ++r) p1[r] = fmaf(p1[r], C2, mnL);
    for (int r = 0; r < 16; ++r) p0[r] = __builtin_amdgcn_exp2f(p0[r]);
}
__device__ __forceinline__ void finishSM(f32x16& p0, f32x16& p1, float alpha, float& l_reg, bf16x8& pa0, bf16x8& pa1, bf16x8& pa2, bf16x8& pa3) {
    for (int r = 0; r < 16; ++r) p1[r] = __builtin_amdgcn_exp2f(p1[r]);
    float ps = 0; for (int r = 0; r < 16; ++r) ps += p0[r]; for (int r = 0; r < 16; ++r) ps += p1[r];
    { auto rr = __builtin_amdgcn_permlane32_swap(__float_as_uint(ps), __float_as_uint(ps), false, false);
      ps = __uint_as_float(rr[0]) + __uint_as_float(rr[1]); }
    l_reg = l_reg * alpha + ps;
#define PK4(P, B_, OUT) do { unsigned a0 = cvtpk(P[B_+0], P[B_+1]), a1 = cvtpk(P[B_+2], P[B_+3]);                          \
        unsigned b0 = cvtpk(P[B_+4], P[B_+5]), b1 = cvtpk(P[B_+6], P[B_+7]);                                             \
        auto r0 = __builtin_amdgcn_permlane32_swap(a0, b0, false, false); auto r1 = __builtin_amdgcn_permlane32_swap(a1, b1, false, false); \
        u32x4 w = {r0[0], r1[0], r0[1], r1[1]}; OUT = *reinterpret_cast<bf16x8*>(&w); } while (0)
    PK4(p0, 0, pa0); PK4(p0, 8, pa1); PK4(p1, 0, pa2); PK4(p1, 8, pa3);
#undef PK4
}
template <int KB>
__device__ __forceinline__ void qkt(f32x16& p0, f32x16& p1, const LAS char* K_lds, int r32, int hi, const bf16x8* qr, const LAS float* cl, int kb, float cref) {
    p0 = f32x16{}; p1 = f32x16{};
    const LAS char* kbp[4];
#pragma unroll
    for (int dd = 0; dd < 4; ++dd) kbp[dd] = K_lds + KB * SHM_K + KSWZ(r32, (dd * 16 + hi * 8) * 2);
#pragma unroll
    for (int d0 = 0; d0 < 8; ++d0) { const LAS char* a = kbp[d0 & 3] + (d0 >> 2) * 128;
        bf16x8 b0 = *reinterpret_cast<const LAS bf16x8*>(a);
        bf16x8 b1 = *reinterpret_cast<const LAS bf16x8*>(a + 32 * 256);
        p0 = __builtin_amdgcn_mfma_f32_32x32x16_bf16(b0, qr[d0], p0, 0, 0, 0);
        p1 = __builtin_amdgcn_mfma_f32_32x32x16_bf16(b1, qr[d0], p1, 0, 0, 0); }
    { const float x0 = (cref - cl[kb + r32]) * INV_SCALE, x1 = (cref - cl[kb + 32 + r32]) * INV_SCALE;
      const unsigned h0 = f2bf(x0), h1 = f2bf(x1); const unsigned l0 = f2bf(x0 - __uint_as_float(h0 << 16)), l1 = f2bf(x1 - __uint_as_float(h1 << 16));
      const u32x4 w0 = {hi == 0 ? (h0 | (l0 << 16)) : 0u, 0u, 0u, 0u}, w1 = {hi == 0 ? (h1 | (l1 << 16)) : 0u, 0u, 0u, 0u}, wq = {hi == 0 ? 0x3F803F80u : 0u, 0u, 0u, 0u};
      p0 = __builtin_amdgcn_mfma_f32_32x32x16_bf16(__builtin_bit_cast(bf16x8, w0), __builtin_bit_cast(bf16x8, wq), p0, 0, 0, 0);
      p1 = __builtin_amdgcn_mfma_f32_32x32x16_bf16(__builtin_bit_cast(bf16x8, w1), __builtin_bit_cast(bf16x8, wq), p1, 0, 0, 0); }
}
template <int VB>
__device__ __forceinline__ void pv_tile(f32x16* o, int vb0, bf16x8 pa0, bf16x8 pa1, bf16x8 pa2, bf16x8 pa3) {
#define TRRD(dst, off) asm volatile("ds_read_b64_tr_b16 %0, %1 offset:%2" : "=&v"(dst) : "v"(vb0), "i"(off) : "memory")
#define PV_D0(d0) do { s16x4 l0, l1, l2, l3, h0, h1, h2, h3; constexpr int b_ = VB * SHM_V + v_rd_off(d0, 0, 0); \
        TRRD(l0, b_); TRRD(h0, b_ + 2048); TRRD(l1, b_ + 4096); TRRD(h1, b_ + 6144); TRRD(l2, b_ + 8192); TRRD(h2, b_ + 10240); TRRD(l3, b_ + 12288); TRRD(h3, b_ + 14336); \
        asm volatile("s_waitcnt lgkmcnt(0)" ::: "memory"); SBAR(); \
        o[d0] = __builtin_amdgcn_mfma_f32_32x32x16_bf16(pa0, (bf16x8){l0[0], l0[1], l0[2], l0[3], h0[0], h0[1], h0[2], h0[3]}, o[d0], 0, 0, 0);   \
        o[d0] = __builtin_amdgcn_mfma_f32_32x32x16_bf16(pa1, (bf16x8){l1[0], l1[1], l1[2], l1[3], h1[0], h1[1], h1[2], h1[3]}, o[d0], 0, 0, 0);   \
        o[d0] = __builtin_amdgcn_mfma_f32_32x32x16_bf16(pa2, (bf16x8){l2[0], l2[1], l2[2], l2[3], h2[0], h2[1], h2[2], h2[3]}, o[d0], 0, 0, 0);   \
        o[d0] = __builtin_amdgcn_mfma_f32_32x32x16_bf16(pa3, (bf16x8){l3[0], l3[1], l3[2], l3[3], h3[0], h3[1], h3[2], h3[3]}, o[d0], 0, 0, 0); } while (0)
    PV_D0(0); PV_D0(1); PV_D0(2); PV_D0(3);
#undef PV_D0
#undef TRRD
}
struct BlockRef { unsigned qo, ko, vo, oo; int P0, hh, grow, t0; };
struct Seam { bf16x8 qr[8]; bf16x8 st_v0, st_v1, st_k0, st_k1; };
#define VMW() asm volatile("s_waitcnt vmcnt(0)" ::: "memory")
#define VMWN(n) asm volatile("s_waitcnt vmcnt(%0)" :: "i"(n) : "memory")
#define GLD8(base, soff, voff) (*(const bf16x8*)((base) + (size_t)(soff) + (voff)))
#define SLOAD_H(kofs, vofs, k0) do { const unsigned t_ = (unsigned)(k0) * (unsigned)(QKV_LD * 2); \
        S.st_v0 = GLD8(zb, (vofs) + t_, kv0); S.st_v1 = GLD8(zb, (vofs) + t_ + 32u * QKV_LD * 2u, kv0); S.st_k0 = GLD8(zb, (kofs) + t_, kv0); S.st_k1 = GLD8(zb, (kofs) + t_ + 32u * QKV_LD * 2u, kv0); } while (0)
#define SWRITE_HK(bf) do { *(LAS bf16x8*)(K_lds + (bf) * SHM_K + kws) = S.st_k0; *(LAS bf16x8*)(K_lds + (bf) * SHM_K + kws + 32 * 256) = S.st_k1; } while (0)
#define SWRITE_HV(bf) do { *(LAS bf16x8*)(V_lds + (bf) * SHM_V + vst0) = S.st_v0; *(LAS bf16x8*)(V_lds + (bf) * SHM_V + vst0 + 8192) = S.st_v1; } while (0)
#define SWRITE_H(bf) do { SWRITE_HV(bf); SWRITE_HK(bf); } while (0)
__device__ __forceinline__ void fox_prime(const int tid, const BlockRef& cur, const char* zb, LAS char* lds, Seam& S) {
    const int wid = __builtin_amdgcn_readfirstlane(tid >> 6), lane = tid & 63, r32 = lane & 31, hi = lane >> 5;
    const int sr = tid >> 4, sc = (tid & 15) * 8, kws = KSWZ(sr, sc * 2); LAS char* K_lds = lds + 2 * SHM_V;
    const unsigned kv0 = (unsigned)(sr * QKV_LD + sc) * 2u, qv = (unsigned)((wid * QBLK + r32) * QKV_LD + hi * 8) * 2u;
#pragma unroll
    for (int d0 = 0; d0 < 8; ++d0) S.qr[d0] = GLD8(zb, cur.qo, qv + d0 * 32);
    SLOAD_H(cur.ko, cur.vo, cur.t0 * KVBLK); VMW(); SWRITE_HK(0);
    __syncthreads();
}
__device__ __forceinline__ void fox_block(const int tid, const BlockRef& cur, const BlockRef& nxt, const char* zb, char* yb, const float* og, float* ssq, LAS char* lds, Seam& S) {
    const int wid = __builtin_amdgcn_readfirstlane(tid >> 6), lane = tid & 63, r32 = lane & 31, hi = lane >> 5;
    const int NT = (cur.P0 + QB - 1) / KVBLK + 1 - cur.t0;
    const int qlo = cur.P0 + wid * QBLK, qm = qlo + r32 - 4 * hi;
    LAS char* V_lds = lds; LAS char* K_lds = lds + 2 * SHM_V;
    LAS float* ws = (LAS float*)(lds + 2 * SHM_V + 2 * SHM_K) + wid * 64; LAS float* li_l = ws; LAS float* al_l = ws + 32;
    const LAS float* cl = (const LAS float*)(lds + LDS_C); const float cref = __int_as_float(__builtin_amdgcn_readfirstlane(__float_as_int(cl[cur.P0])));
    float m_reg = -1e30f, l_reg = 0; f32x16 o[4] = {};
    const int sr = tid >> 4, sc = (tid & 15) * 8, vst0 = v_st(sr, sc), kws = KSWZ(sr, sc * 2);
    const unsigned kv0 = (unsigned)(sr * QKV_LD + sc) * 2u;
    const int vb0 = (int)(unsigned)(size_t)V_lds + v_rd_base(lane);
#define RESC(a) do { if (__any((a) < 1.f)) { if (hi == 0) al_l[r32] = (a); asm volatile("s_waitcnt lgkmcnt(0)" ::: "memory");              \
                     for (int d_ = 0; d_ < 4; ++d_) for (int r = 0; r < 16; ++r) o[d_][r] *= al_l[crow(r, hi)]; } } while (0)
#define KBASE(t) (((t) + cur.t0) * KVBLK)
#define MASKT(P0_, P1_, t) do { const int kb_ = KBASE(t); if (kb_ + KVBLK - 1 > qlo) mask_tile(P0_, P1_, qm - kb_); } while (0)
    constexpr int NQL = 8;
#define SEAM_K0() do { VMWN(NQL); SWRITE_HK(0); SBAR(); } while (0)
    f32x16 pA0, pA1, pB0, pB1; float mnA, mnB, alA, alB; bf16x8 pa0, pa1, pa2, pa3;
    SWRITE_HV(0); SBAR();
    if (NT > 1) { SLOAD_H(cur.ko, cur.vo, KBASE(1)); }
    SBAR(); qkt<0>(pA0, pA1, K_lds, r32, hi, S.qr, cl, KBASE(0), cref);
    MASKT(pA0, pA1, 0); partialSM(pA0, pA1, m_reg, mnA, alA);
    if (NT > 1) { VMW(); SWRITE_H(1); }
    __syncthreads();
#define HALF_STEP(PX0, PX1, mnX, alX, PY0, PY1, alY, t, KB, VB, SB) do {                                                      \
        SBAR(); qkt<KB>(PX0, PX1, K_lds, r32, hi, S.qr, cl, KBASE(t), cref);                                                  \
        finishSM(PY0, PY1, alY, l_reg, pa0, pa1, pa2, pa3); SBAR();                                                           \
        if ((t) + 1 < NT) { SLOAD_H(cur.ko, cur.vo, KBASE((t) + 1)); SBAR(); }                                                \
        pv_tile<VB>(o, vb0, pa0, pa1, pa2, pa3); MASKT(PX0, PX1, (t)); partialSM(PX0, PX1, m_reg, mnX, alX);                 \
        __syncthreads();                                                                                                      \
        if ((t) + 1 < NT) { VMW(); SWRITE_H(SB); }                                                                            \
        RESC(alX); __syncthreads(); } while (0)
    for (int t = 1; t + 1 < NT; t += 2) {
        HALF_STEP(pB0, pB1, mnB, alB, pA0, pA1, alA, t, 1, 0, 0);
        HALF_STEP(pA0, pA1, mnA, alA, pB0, pB1, alB, t + 1, 0, 1, 1);
    }
    const bool even = (NT & 1) == 0;
    if (even) { SBAR(); qkt<1>(pB0, pB1, K_lds, r32, hi, S.qr, cl, KBASE(NT - 1), cref); SBAR(); }
    SLOAD_H(nxt.ko, nxt.vo, nxt.t0 * KVBLK); SBAR();
    { const unsigned qv = (unsigned)((wid * QBLK + r32) * QKV_LD + hi * 8) * 2u;
#pragma unroll
      for (int d0 = 0; d0 < 8; ++d0) S.qr[d0] = GLD8(zb, nxt.qo, qv + d0 * 32); }
    SBAR();
    finishSM(pA0, pA1, alA, l_reg, pa0, pa1, pa2, pa3); SBAR();
    pv_tile<0>(o, vb0, pa0, pa1, pa2, pa3);
    if (even) { MASKT(pB0, pB1, NT - 1); partialSM(pB0, pB1, m_reg, mnB, alB); __syncthreads(); RESC(alB);
        finishSM(pB0, pB1, alB, l_reg, pa0, pa1, pa2, pa3); SBAR(); pv_tile<1>(o, vb0, pa0, pa1, pa2, pa3); }
    SBAR(); SEAM_K0();
    if (hi == 0) li_l[r32] = l_reg; asm volatile("s_waitcnt lgkmcnt(0)" ::: "memory");
    float rli[16];
#pragma unroll
    for (int r = 0; r < 16; ++r) rli[r] = __builtin_amdgcn_rcpf(li_l[crow(r, hi)]);
    const unsigned ov = (unsigned)((wid * QBLK + 4 * hi) * O_LD + r32) * 2u;
    float gq[4];
#pragma unroll
    for (int d0 = 0; d0 < 4; ++d0) gq[d0] = og[cur.hh * DH + d0 * 32 + r32];
    float qs[16];
#pragma unroll
    for (int r = 0; r < 16; ++r) { const unsigned orow = (unsigned)(((r & 3) + 8 * (r >> 2)) * O_LD * 2); float q = 0.f;
#pragma unroll
        for (int d0 = 0; d0 < 4; ++d0) { const float v = o[d0][r] * rli[r]; q += v * v;
            const float vg = v * gq[d0], vn = swz_xor<1>(vg);
            if ((r32 & 1) == 0) *(unsigned*)(yb + (size_t)(cur.oo + orow + d0 * 64) + ov) = cvtpk(vg, vn); }
        qs[r] = q; }
    { const bool b0 = (r32 & 1) != 0, b1 = (r32 & 2) != 0, b2 = (r32 & 4) != 0, b3 = (r32 & 8) != 0;
      float a8[8], a4[4], a2[2];
#pragma unroll
      for (int i = 0; i < 8; ++i) { const float x = qs[2 * i] + swz_xor<1>(qs[2 * i]), y = qs[2 * i + 1] + swz_xor<1>(qs[2 * i + 1]); a8[i] = b0 ? y : x; }
#pragma unroll
      for (int i = 0; i < 4; ++i) { const float x = a8[2 * i] + swz_xor<2>(a8[2 * i]), y = a8[2 * i + 1] + swz_xor<2>(a8[2 * i + 1]); a4[i] = b1 ? y : x; }
#pragma unroll
      for (int i = 0; i < 2; ++i) { const float x = a4[2 * i] + swz_xor<4>(a4[2 * i]), y = a4[2 * i + 1] + swz_xor<4>(a4[2 * i + 1]); a2[i] = b2 ? y : x; }
      const float x = a2[0] + swz_xor<8>(a2[0]), y = a2[1] + swz_xor<8>(a2[1]); float tot = b3 ? y : x; tot += swz_xor<16>(tot);
      const int rr_ = r32 & 15;
      if (r32 < 16) ssq[(size_t)(cur.grow + wid * QBLK + ((rr_ & 3) + 8 * (rr_ >> 2)) + 4 * hi) * 8 + cur.hh] = tot; }
    __syncthreads();
#undef RESC
#undef KBASE
#undef MASKT
#undef SEAM_K0
#undef HALF_STEP
}
#undef VMW
#undef VMWN
#undef GLD8
#undef SLOAD_H
#undef SWRITE_HK
#undef SWRITE_HV
#undef SWRITE_H
#undef KSWZ
#undef SBAR
}

template <int MODE>
__device__ __forceinline__ void cvt_item(const float* W, int ldw, int K, bf16_t* WT, int rowadd, LAS float* scr, int kb, int nb, int lane, int krot = 0) {
    const int k0 = 64 * kb, n0 = 32 * nb, kd0 = (k0 + krot) & (K - 1);
#pragma unroll 8
    for (int i = 0; i < 32; ++i) { const int kk = 2 * i + (lane >> 5); scr[kk * 33 + (lane & 31)] = W[(size_t)(k0 + kk) * ldw + n0 + (lane & 31)]; }
    asm volatile("s_waitcnt lgkmcnt(0)" ::: "memory");
    const int c = lane & 7;
#pragma unroll
    for (int j = 0; j < 4; ++j) { const int n = (lane >> 3) + 8 * j; const LAS float* sp = scr + (8 * c) * 33 + n; const int nn = n0 + n;
        const int drow = rowadd + (MODE ? 8 * (nn >> 2) + (nn & 3) : nn);
        uint4 o; o.x = pk2(sp[0 * 33], sp[1 * 33]); o.y = pk2(sp[2 * 33], sp[3 * 33]); o.z = pk2(sp[4 * 33], sp[5 * 33]); o.w = pk2(sp[6 * 33], sp[7 * 33]);
        *(uint4*)(WT + (size_t)drow * K + kd0 + 8 * c) = o; }
    asm volatile("s_waitcnt lgkmcnt(0)" ::: "memory");
}

template <int MODE>
__device__ __forceinline__ void cvt_item8(const float* W, int ldw, int K, unsigned char* WT, int rowadd, LAS float* scr, int kb, int nb, int lane) {
    const int k0 = 64 * kb, n0 = 32 * nb;
#pragma unroll 8
    for (int i = 0; i < 32; ++i) { const int kk = 2 * i + (lane >> 5); scr[kk * 33 + (lane & 31)] = W[(size_t)(k0 + kk) * ldw + n0 + (lane & 31)]; }
    asm volatile("s_waitcnt lgkmcnt(0)" ::: "memory");
    const int c = lane & 7;
#pragma unroll
    for (int j = 0; j < 4; ++j) { const int n = (lane >> 3) + 8 * j; const LAS float* sp = scr + (8 * c) * 33 + n; const int nn = n0 + n;
        const int drow = rowadd + (MODE ? 8 * (nn >> 2) + (nn & 3) : nn);
        uint2 o; o.x = pk4_fp8(sp[0 * 33] * W8_SCALE, sp[1 * 33] * W8_SCALE, sp[2 * 33] * W8_SCALE, sp[3 * 33] * W8_SCALE); o.y = pk4_fp8(sp[4 * 33] * W8_SCALE, sp[5 * 33] * W8_SCALE, sp[6 * 33] * W8_SCALE, sp[7 * 33] * W8_SCALE);
        *(uint2*)(WT + (size_t)drow * K + k0 + 8 * c) = o; }
    asm volatile("s_waitcnt lgkmcnt(0)" ::: "memory");
}

struct Args { const float* in[29]; float* out; unsigned char* ws; int ph_lo, ph_hi, li, pad; };

__global__ void __launch_bounds__(512, 2) fwd_kernel(Args a) {
    extern __shared__ __attribute__((aligned(16))) unsigned char lds_raw[];
    LAS unsigned char* const lds0_ = (LAS unsigned char*)lds_raw;
    volatile LAS unsigned* MISC = (volatile LAS unsigned*)(lds0_ + MISC_OFF);
    const int wave0 = __builtin_amdgcn_readfirstlane((int)threadIdx.x >> 6);
    const int tid0 = threadIdx.x;
    const int wg0 = blockIdx.x, nwg0 = gridDim.x;
#define PHASE_IDS const __attribute__((address_space(4))) Args* ap_ = (const __attribute__((address_space(4))) Args*)__builtin_amdgcn_kernarg_segment_ptr(); int wg = wg0, nwg = nwg0; LAS unsigned char* lds = lds0_; asm volatile("" : "+s"(ap_), "+s"(wg), "+s"(nwg), "+s"(lds)); LAS float* const ldsf = (LAS float*)lds; (void)ldsf; unsigned char* ws = ap_->ws; unsigned* const ctl = (unsigned*)(ws + WS_CTL); (void)ctl; int zv_ = 0; asm volatile("" : "+v"(zv_)); int tid = (wave0 << 6) | (int)__builtin_amdgcn_mbcnt_hi(~0u, __builtin_amdgcn_mbcnt_lo(~0u, (unsigned)zv_)); asm volatile("" : "+v"(tid)); const int lane = tid & 63, wave = __builtin_amdgcn_readfirstlane(tid >> 6); (void)lane; (void)wave;
#define NRMP ((unsigned*)(ws + WS_CTL + 600 * 1024) + l * 512)
#define ASG ((int*)(ws + WS_ASG))
#define GATE ((float*)(ws + WS_GATE))
#define FL ((float*)(ws + WS_F))
#define TOKL ((int*)(ws + WS_TOKL))
#define XB ((bf16_t*)(ws + WS_X))
#define HB ((bf16_t*)(ws + WS_H))
#define Z ((bf16_t*)(ws + WS_BIG + BIG_Z))
#define Y ((bf16_t*)(ws + WS_BIG + BIG_Y))
#define PE ((bf16_t*)(ws + WS_BIG + BIG_PE))
#define Y2 ((bf16_t*)(ws + WS_BIG))
#define PB ((bf16_t*)(ws + WS_PB))
#define WR ((bf16_t*)(ws + WS_W))
#define WIN_T (WR + WO_WIN)
#define WO_T (WR + WO_WO)
#define W13_T (WR + WO_W13)
#define W2_T (WR + WO_W2)
#define WPE_T (WR + WO_WPE)
#define WPG_T (WR + WO_WPG)
#define WF_T (WR + WO_WF)
#define U1 (ap_->out)

    if (tid0 < 32) MISC[tid0] = 0u;
    __syncthreads();
    const int lo = a.ph_lo, hi = a.ph_hi;
    XcdBarrier bar; bar.bar = (unsigned*)(a.ws + WS_CTL) + CW_BAR + a.li * CW_BAR_STRIDE; bar.x = 0; bar.st = MISC + 8;
    if (hi - lo > 1) bar = xcd_barrier_post((unsigned*)(a.ws + WS_CTL) + CW_BAR + a.li * CW_BAR_STRIDE, MISC + 8);
#ifndef PHMASK
#define PHMASK 0x3ff
#endif
#define IN(k) ((((PHMASK) >> ((k) == 0 ? 0 : 1 + ((k) - 1) % PPL)) & 1) && lo <= (k) && (k) < hi)
#define SEAM(k) do { if ((k) + 1 < hi) { XcdBarrier bl_ = bar; asm volatile("" : "+s"(bl_.bar), "+s"(bl_.x)); xcd_barrier(bl_); } } while (0)

    if (IN(0)) {
        PHASE_IDS
        const float4* x4 = (const float4*)ap_->in[0]; uint2* o2 = (uint2*)XB;
        for (size_t i = (size_t)wg * 512 + tid; i < (size_t)T * D / 4; i += (size_t)nwg * 512) { const float4 v = x4[i]; uint2 o; o.x = pk2(v.x, v.y); o.y = pk2(v.z, v.w); o2[i] = o; ((unsigned*)(ws + WS_XB8))[i] = pk4_fp8(v.x, v.y, v.z, v.w); }
        const float4* p4 = (const float4*)ap_->in[1]; uint2* q2 = (uint2*)PB;
        for (size_t i = (size_t)wg * 512 + tid; i < (size_t)DEPTH * T * DPLE / 4; i += (size_t)nwg * 512) { const float4 v = p4[i]; uint2 o; o.x = pk2(v.x, v.y); o.y = pk2(v.z, v.w); q2[i] = o; }
        SEAM(0);
    }

#define w_in (ap_->in[2] + (size_t)l * D * N_IN)
#define b_f (ap_->in[3] + l * AH)
#define conv_w (ap_->in[4] + (size_t)l * CONV_W * CONV_CH)
#define conv_b (ap_->in[5] + l * CONV_CH)
#define conv_ln_g (ap_->in[6] + l * CONV_CH)
#define conv_ln_b (ap_->in[7] + l * CONV_CH)
#define gm_ln_g (ap_->in[8] + l * GM_CH)
#define gm_ln_b (ap_->in[9] + l * GM_CH)
#define w_sp (ap_->in[10] + (size_t)l * 4 * CHUNK * CHUNK)
#define b_sp (ap_->in[11] + l * 4 * CHUNK)
#define out_g (ap_->in[12] + l * D)
#define w_o (ap_->in[13] + (size_t)l * D * D)
#define ln1_g (ap_->in[14] + l * D)
#define ln1_b (ap_->in[15] + l * D)
#define w_r (ap_->in[16] + (size_t)l * D * NE)
#define r_bias (ap_->in[17] + l * NE)
#define w_e1 (ap_->in[18] + (size_t)l * NE * D * DE)
#define w_e3 (ap_->in[19] + (size_t)l * NE * D * DE)
#define w_e2 (ap_->in[20] + (size_t)l * NE * DE * D)
#define w_sh1 (ap_->in[21] + (size_t)l * D * DE)
#define w_sh3 (ap_->in[22] + (size_t)l * D * DE)
#define w_sh2 (ap_->in[23] + (size_t)l * DE * D)
#define w_pe (ap_->in[24] + (size_t)l * DPLE * D)
#define w_pg (ap_->in[25] + (size_t)l * D * D)
#define b_pg (ap_->in[26] + l * D)
#define ln2_g (ap_->in[27] + l * D)
#define ln2_b (ap_->in[28] + l * D)
#define pin (ap_->in[1] + (size_t)l * T * DPLE)
#define cntg (ctl + CW_CNT + l * 64 * 64)
    for (int l = 0; l < DEPTH; ++l) {
        const int pb = 1 + PPL * l;

        if (IN(pb + 0)) {
            PHASE_IDS
            LAS float* scr = ldsf + wave * (64 * 33);
            const int gw = wg * 8 + wave, NGW = nwg * 8;
            constexpr int I_IN = 32 * 64 + 32 * 96, I_O = 32 * 64, I_E13 = NE * 2 * 32 * 16, I_S13 = 2 * 32 * 16, I_E2 = NE * 8 * 64, I_S2 = 8 * 64, I_PE = 4 * 64, I_PG = 32 * 64;
            constexpr int NITEMS = I_IN + I_O + I_E13 + I_S13 + I_E2 + I_S2 + I_PE + I_PG;
            for (int it = gw; it < NITEMS; it += NGW) {
                int r = it;
                if (r < 32 * 64) { cvt_item<0>(w_in, N_IN, D, WIN_T, 0, scr, r / 64, r % 64, lane); continue; }
                if (r < I_IN) { const int r2 = r - 32 * 64; cvt_item8<0>(w_in + OFF_Q, N_IN, D, (unsigned char*)(WIN_T + (size_t)OFF_Q * D), 0, scr, r2 / 96, r2 % 96, lane); continue; } r -= I_IN;
                if (r < I_O) { cvt_item<0>(w_o, D, D, WO_T, 0, scr, r / 64, r % 64, lane, 1024); continue; } r -= I_O;
                if (r < I_E13) { const int e = r >> 10, r2 = r & 1023, which = r2 >> 9, r3 = r2 & 511;
                    if (USE_FP8) cvt_item8<1>((which ? w_e3 : w_e1) + (size_t)e * D * DE, DE, D, (unsigned char*)W13_T, e * 1024 + 4 * which, scr, r3 >> 4, r3 & 15, lane); else cvt_item<1>((which ? w_e3 : w_e1) + (size_t)e * D * DE, DE, D, W13_T, e * 1024 + 4 * which, scr, r3 >> 4, r3 & 15, lane); continue; } r -= I_E13;
                if (r < I_S13) { const int which = r >> 9, r3 = r & 511; if (USE_FP8) cvt_item8<1>(which ? w_sh3 : w_sh1, DE, D, (unsigned char*)W13_T, 64 * 1024 + 4 * which, scr, r3 >> 4, r3 & 15, lane); else cvt_item<1>(which ? w_sh3 : w_sh1, DE, D, W13_T, 64 * 1024 + 4 * which, scr, r3 >> 4, r3 & 15, lane); continue; } r -= I_S13;
                if (r < I_E2) { const int e = r >> 9, r2 = r & 511; if (USE_FP8) cvt_item8<0>(w_e2 + (size_t)e * DE * D, D, DE, (unsigned char*)W2_T, e * D, scr, r2 >> 6, r2 & 63, lane); else cvt_item<0>(w_e2 + (size_t)e * DE * D, D, DE, W2_T, e * D, scr, r2 >> 6, r2 & 63, lane); continue; } r -= I_E2;
                if (r < I_S2) { if (USE_FP8) cvt_item8<0>(w_sh2, D, DE, (unsigned char*)W2_T, 64 * D, scr, r >> 6, r & 63, lane); else cvt_item<0>(w_sh2, D, DE, W2_T, 64 * D, scr, r >> 6, r & 63, lane); continue; } r -= I_S2;
                if (r < I_PE) { cvt_item<0>(w_pe, D, DPLE, WPE_T, 0, scr, r >> 6, r & 63, lane); continue; } r -= I_PE;
                if (USE_FP8) cvt_item8<0>(w_pg, D, D, (unsigned char*)WPG_T, 0, scr, r >> 6, r & 63, lane); else cvt_item<0>(w_pg, D, D, WPG_T, 0, scr, r >> 6, r & 63, lane);
            }
            if (wg == 0) for (int i = tid; i < 8 * D; i += 512) { const int h = i / D, k = i % D; WF_T[i] = (bf16_t)f2bf(w_in[(size_t)k * N_IN + OFF_F + h]); }
            if (wg < 128) { const int i = wg * 512 + tid; const int t_ = (i >> 7) & 127, s_ = i & 127; (WR + WO_WSP)[i] = (bf16_t)(s_ <= t_ ? f2bf(w_sp[i]) : 0u); }
            if (wg < 256) for (int i = wg * 512 + tid; i < NE * D; i += 256 * 512) { const int e = i / D, k = i % D; const float w = w_r[(size_t)k * NE + e]; const unsigned hb = f2bf(w); (WR + WO_WR)[i] = (bf16_t)hb; (WR + WO_WR)[NE * D + i] = (bf16_t)f2bf(w - __uint_as_float(hb << 16)); }
            SEAM(pb + 0);
        }

        if (IN(pb + 1)) {
            PHASE_IDS
            { g8::DenseSched S{(const char*)XB, (const char*)WIN_T, nullptr, T / 256, OFF_Q / 256, D, nwg, wg}; g8::EpiZ E{Z, 0, nullptr};
              g8::gemm_phase(tid, lds, D, S, E); }
            { int tid2 = tid; asm volatile("" : "+v"(tid2));
              g8::MoeSched S{0, 0, 0, 0, 0, (const char*)(ws + WS_XB8), (const char*)(WIN_T + (size_t)OFF_Q * D), 0u, 0u, nullptr, T / 256, (ZW - OFF_Q) / 256, 0u, D / 2, nwg, wg}; g8::EpiZ E{Z, OFF_Q, NRMP};
              g8::gemm_phase<g8::EpiZ, g8::MoeSched, true>(tid2, lds, D / 2, S, E); }
            { const int fr = lane & 15, fq = lane >> 4;
              for (int tile = wg * 8 + wave; tile < T / 16; tile += nwg * 8) {
                  const bf16_t* ap = XB + (size_t)(tile * 16 + fr) * D + fq * 8; const bf16_t* bp = WF_T + (size_t)(fr & 7) * D + fq * 8;
                  f32x4 acc = {0.f, 0.f, 0.f, 0.f};
#pragma unroll 8
                  for (int ks = 0; ks < D / 32; ++ks) { const g8::bf16x8 av = *(const g8::bf16x8*)(ap + ks * 32); g8::bf16x8 bv = *(const g8::bf16x8*)(bp + ks * 32);
                      if (fr >= 8) bv = (g8::bf16x8){0, 0, 0, 0, 0, 0, 0, 0};
                      acc = __builtin_amdgcn_mfma_f32_16x16x32_bf16(bv, av, acc, 0, 0, 0); }
                  if (fq < 2) *(f32x4*)(FL + (size_t)(tile * 16 + fr) * 8 + 4 * fq) = acc; } }
            SEAM(pb + 1);
        }

        if (IN(pb + 2)) {
            PHASE_IDS
            constexpr int NGM = NB * (S / CHUNK);
            {
                LAS char* ldsa = (LAS char*)lds; LAS float* cl = (LAS float*)(ldsa + att::LDS_C); LAS float* wtot = cl + S; const char* zb = (const char*)Z; char* yb = (char*)Y;
                constexpr int NIT = NB * AH * (att::NQB / 2);
#define FOX_REF(L_, pass_, R_, prune_) do { const int bh_ = (L_) >> 3, x_ = (L_) & 7, b_ = bh_ >> 3, h_ = bh_ & 7, qb_ = (pass_) ? att::NQB - 1 - x_ : x_; const unsigned zo_ = (unsigned)(b_ * S) * (unsigned)(ZW * 2) + (unsigned)(h_ * HD * 2); \
        (R_).qo = zo_ + OFF_Q * 2 + (unsigned)(qb_ * att::QB) * (unsigned)(ZW * 2); (R_).ko = zo_ + OFF_K * 2; (R_).vo = zo_ + OFF_V * 2; (R_).oo = (unsigned)(b_ * S + qb_ * att::QB) * (unsigned)(D * 2) + (unsigned)((YC_ATT + h_ * HD) * 2); (R_).P0 = qb_ * att::QB; (R_).hh = h_; (R_).grow = b_ * S + qb_ * att::QB; (R_).t0 = 0; \
        if (prune_) { const float thr_ = FOX_RFL(cl[(R_).P0]) + thr_add; int lo_ = 0, hi_ = (R_).P0 / att::KVBLK;     \
            while (lo_ < hi_) { const int mid_ = (lo_ + hi_ + 1) >> 1; if (FOX_RFL(cl[att::KVBLK * mid_ - 1]) > thr_) lo_ = mid_; else hi_ = mid_ - 1; } (R_).t0 = lo_; } } while (0)
#define FOX_RFL(x_) __int_as_float(__builtin_amdgcn_readfirstlane(__float_as_int(x_)))
#define FOX_CUMSUM(L_) do { int t2_ = tid; asm volatile("" : "+v"(t2_)); const int lane2_ = t2_ & 63, wave2_ = __builtin_amdgcn_readfirstlane(t2_ >> 6); const int bh_ = (L_) >> 3, b_ = bh_ >> 3, h_ = bh_ & 7; const float bfh_ = b_f[h_]; const float* fp_ = FL + (size_t)b_ * S * 8 + h_; float loc_[8]; float run_ = 0.f; \
        _Pragma("unroll") for (int j_ = 0; j_ < 8; ++j_) { const float x_ = fp_[(size_t)(t2_ * 8 + j_) * 8] + bfh_; run_ += fminf(x_, 0.f) - log1pf(__expf(-fabsf(x_))); loc_[j_] = run_; } \
        float v_ = run_; _Pragma("unroll") for (int o_ = 1; o_ < 64; o_ <<= 1) { const float n_ = lane_up(v_, lane2_, o_); if (lane2_ >= o_) v_ += n_; } \
        if (lane2_ == 63) wtot[wave2_] = v_; __syncthreads(); float woff_ = 0.f; for (int w2_ = 0; w2_ < wave2_; ++w2_) woff_ += wtot[w2_]; const float off_ = woff_ + v_ - run_; \
        _Pragma("unroll") for (int j_ = 0; j_ < 8; ++j_) cl[t2_ * 8 + j_] = loc_[j_] + off_; \
        { unsigned* nq_ = NRMP + bh_ * 4; unsigned* nk_ = NRMP + (64 + bh_) * 4; float q2_ = 0.f, k2_ = 0.f; \
          _Pragma("unroll") for (int w_ = 0; w_ < 4; ++w_) { q2_ += __uint_as_float(xb_ld(nq_ + w_)); k2_ += __uint_as_float(xb_ld(nk_ + w_)); } \
          thr_add = 2.f * 1.02f * att::SCALE * sqrtf(q2_ * k2_) + 28.f; } \
        __syncthreads(); } while (0)
                int hm_wg = (wg >> 3) & 7;
                if ((nwg & 63) == 0) { const int h_ = hm_wg; const float bh_ = b_f[h_]; int rk_ = 0;
#pragma unroll
                    for (int j = 0; j < 8; ++j) { const float bj_ = b_f[j]; rk_ += (bj_ > bh_ || (bj_ == bh_ && j < h_)) ? 1 : 0; }
#pragma unroll
                    for (int i = 0; i < 8; ++i) { const float bi_ = b_f[i]; int r_ = 0;
#pragma unroll
                        for (int j = 0; j < 8; ++j) { const float bj_ = b_f[j]; r_ += (bj_ > bi_ || (bj_ == bi_ && j < i)) ? 1 : 0; }
                        if (r_ == 7 - rk_) hm_wg = i; }
                    hm_wg = __builtin_amdgcn_readfirstlane(hm_wg); }
#define FOX_ITEM(L_) (((((L_) / nwg) & 1) == 0 || (nwg & 7) != 0) ? (L_) : (((L_) & ~63) | (((nwg & 63) == 0 ? hm_wg : (((L_) >> 3) & 7)) << 3) | (((L_) & 7) ^ 7)))
                int L = wg, pass = 0;
                if (L < NIT) {
                    att::Seam Sm; att::BlockRef cur, nxt; float thr_add = 0.f;
                    FOX_CUMSUM(FOX_ITEM(L)); FOX_REF(FOX_ITEM(L), 0, cur, true);
                    att::fox_prime(tid, cur, zb, ldsa, Sm);
                    for (;;) {
                        const bool more_pass = pass == 0, more_item = L + nwg < NIT, last = !more_pass && !more_item;
                        int Ln = L, passn = pass + 1; if (!more_pass) { passn = 0; Ln = more_item ? L + nwg : L; }
                        if (last) nxt = cur; else FOX_REF(FOX_ITEM(Ln), passn, nxt, passn == 1);
                        att::fox_block(tid, cur, nxt, zb, yb, out_g + 1024, (float*)(ws + WS_SSQ), ldsa, Sm);
                        if (last) break;
                        if (passn == 0) FOX_CUMSUM(FOX_ITEM(Ln));
                        cur = nxt; L = Ln; pass = passn;
                    }
                }
#undef FOX_REF
#undef FOX_ITEM
#undef FOX_CUMSUM
#undef FOX_RFL
            }
            __syncthreads();
            for (int u = wg; u < NGM; u += nwg) {
                __syncthreads();
                {
                    const int b = u / (S / CHUNK), n = u % (S / CHUNK); const size_t row0 = (size_t)b * S + n * CHUNK;
                    constexpr int VRS = 272;
                    LAS unsigned char* vt = lds;
                    LAS float* st = (LAS float*)(lds + 4 * 128 * VRS);
                    static_assert(4 * 128 * VRS + 1024 <= MISC_OFF, "gMLP LDS map");
#pragma unroll
                    for (int hb = 0; hb < 2; ++hb) { g8::u32x4 xr[8];
#pragma unroll
                      for (int i = 0; i < 8; ++i) xr[i] = *(const g8::u32x4*)(Z + (row0 + wave * 16 + hb * 8 + i) * ZW + 1536 + lane * 8);
                      asm volatile("" : "+v"(xr[0]), "+v"(xr[1]), "+v"(xr[2]), "+v"(xr[3]), "+v"(xr[4]), "+v"(xr[5]), "+v"(xr[6]), "+v"(xr[7]));
#pragma unroll
                      for (int i = 0; i < 8; ++i) { const int sp = wave * 16 + hb * 8 + i; const g8::u32x4 xv = xr[i];
                        const float x[8] = {bflo(xv.x), bfhi(xv.x), bflo(xv.y), bfhi(xv.y), bflo(xv.z), bfhi(xv.z), bflo(xv.w), bfhi(xv.w)}; float sum = 0.f;
#pragma unroll
                        for (int j = 0; j < 8; ++j) sum += x[j];
                        const float mean = wave_sum(sum) * (1.f / 512.f); float q = 0.f;
#pragma unroll
                        for (int j = 0; j < 8; ++j) { const float dd = x[j] - mean; q += dd * dd; }
                        const float rstd = rsqrtf(wave_sum(q) * (1.f / 512.f) + LN_EPS);
                        st[sp * 2] = mean; st[sp * 2 + 1] = rstd; } }
                    __syncthreads();
#pragma unroll 4
                    for (int it = 0; it < 16; ++it) { const int q = it * 512 + tid, c8 = q >> 7, sp = q & 127; const uint4 xv = *(const uint4*)(Z + (row0 + sp) * ZW + 1536 + c8 * 8);
                        const float mean = st[sp * 2], rstd = st[sp * 2 + 1]; const float4 g0 = *(const float4*)(gm_ln_g + c8 * 8), g1 = *(const float4*)(gm_ln_g + c8 * 8 + 4), b0 = *(const float4*)(gm_ln_b + c8 * 8), b1 = *(const float4*)(gm_ln_b + c8 * 8 + 4);
                        const float x[8] = {bflo(xv.x), bfhi(xv.x), bflo(xv.y), bfhi(xv.y), bflo(xv.z), bfhi(xv.z), bflo(xv.w), bfhi(xv.w)};
                        const float gg[8] = {g0.x, g0.y, g0.z, g0.w, g1.x, g1.y, g1.z, g1.w}, bb[8] = {b0.x, b0.y, b0.z, b0.w, b1.x, b1.y, b1.z, b1.w};
                        LAS unsigned char* dst = vt + (c8 * 8) * VRS + sp * 2;
#pragma unroll
                        for (int j = 0; j < 8; ++j) *(LAS bf16_t*)(dst + j * VRS) = (bf16_t)f2bf((x[j] - mean) * rstd * gg[j] + bb[j]); }
                    __syncthreads();
                    const int fr = lane & 15, fq = lane >> 4; const int t = wave * 16 + fr;
                    const bf16_t* WSP = WR + WO_WSP;
                    unsigned ypk[4][8][2]; float ss = 0.f;
#pragma unroll
                    for (int h = 0; h < 4; ++h) {
                        f32x4 acc[8];
#pragma unroll
                        for (int cb = 0; cb < 8; ++cb) acc[cb] = (f32x4){0.f, 0.f, 0.f, 0.f};
                        g8::bf16x8 wv[4]; g8::u32x2 uvv[8]; float bs = b_sp[h * 128 + t];
#pragma unroll
                        for (int ks = 0; ks < 4; ++ks) wv[ks] = *(const g8::bf16x8*)(WSP + (size_t)(h * 128 + t) * 128 + ks * 32 + fq * 8);
#pragma unroll
                        for (int cb = 0; cb < 8; ++cb) uvv[cb] = *(const g8::u32x2*)(Z + (row0 + t) * ZW + 1024 + h * 128 + cb * 16 + fq * 4);
                        asm volatile("" : "+v"(wv[0]), "+v"(wv[1]), "+v"(wv[2]), "+v"(wv[3]), "+v"(uvv[0]), "+v"(uvv[1]), "+v"(uvv[2]), "+v"(uvv[3]), "+v"(uvv[4]), "+v"(uvv[5]), "+v"(uvv[6]), "+v"(uvv[7]), "+v"(bs));
#pragma unroll
                        for (int ks = 0; ks < 4; ++ks) {
#pragma unroll
                            for (int cb = 0; cb < 8; ++cb) { const g8::bf16x8 xv = *(const LAS g8::bf16x8*)(vt + (h * 128 + cb * 16 + fr) * VRS + (ks * 32 + fq * 8) * 2);
                                acc[cb] = __builtin_amdgcn_mfma_f32_16x16x32_bf16(xv, wv[ks], acc[cb], 0, 0, 0); } }
#pragma unroll
                        for (int cb = 0; cb < 8; ++cb) { const g8::u32x2 uv = uvv[cb];
                            const float y0 = bflo(uv.x) * (acc[cb][0] + bs), y1 = bfhi(uv.x) * (acc[cb][1] + bs), y2 = bflo(uv.y) * (acc[cb][2] + bs), y3 = bfhi(uv.y) * (acc[cb][3] + bs);
                            ss += (y0 * y0 + y1 * y1) + (y2 * y2 + y3 * y3); ypk[h][cb][0] = pk2(y0, y1); ypk[h][cb][1] = pk2(y2, y3); }
                    }
                    ss += swz_xor<16>(ss); { const auto rr = __builtin_amdgcn_permlane32_swap(__float_as_uint(ss), __float_as_uint(ss), false, false); ss = __uint_as_float(rr[0]) + __uint_as_float(rr[1]); }
                    const float rr_ = rsqrtf(ss * (1.f / 512.f) + LN_EPS);
#pragma unroll
                    for (int h = 0; h < 4; ++h) { f32x4 ogv[8];
#pragma unroll
                        for (int cb = 0; cb < 8; ++cb) ogv[cb] = *(const f32x4*)(out_g + 512 + h * 128 + cb * 16 + fq * 4);
                        asm volatile("" : "+v"(ogv[0]), "+v"(ogv[1]), "+v"(ogv[2]), "+v"(ogv[3]), "+v"(ogv[4]), "+v"(ogv[5]), "+v"(ogv[6]), "+v"(ogv[7]));
#pragma unroll
                        for (int cb = 0; cb < 8; ++cb) { const int c = 512 + h * 128 + cb * 16 + fq * 4; const f32x4 og = ogv[cb];
                            uint2 o; o.x = pk2(bflo(ypk[h][cb][0]) * rr_ * og.x, bfhi(ypk[h][cb][0]) * rr_ * og.y); o.y = pk2(bflo(ypk[h][cb][1]) * rr_ * og.z, bfhi(ypk[h][cb][1]) * rr_ * og.w);
                            *(uint2*)(Y + (row0 + t) * D + (YC_GMLP - 512) + c) = o; } }
                }
            }
            for (int u = wg; u < T / 64; u += nwg) {
                __syncthreads();
                {
                    const int b = u / (S / 64), s0 = (u % (S / 64)) * 64; const int cp = tid & 255, ph = __builtin_amdgcn_readfirstlane(tid >> 8);
                    LAS float* cv = ldsf;
                    { f32x2 acc[32], wv[31]; const f32x2 cb2 = *(const f32x2*)(conv_b + 2 * cp); const char* cwb = (const char*)conv_w;
#pragma unroll
                      for (int j = 0; j < 31; ++j) { const char* pj = cwb + j * 2048; asm volatile("" : "+s"(pj)); wv[j] = *(const f32x2*)(pj + (unsigned)(8 * cp)); }
#pragma unroll
                      for (int t = 0; t < 32; ++t) acc[t] = cb2;
                      const int p0 = s0 + 32 * ph - 30;
#pragma unroll
                      for (int bt = 0; bt < 4; ++bt) { g8::u32x4 pa[4] = {}, pg[4] = {};
#pragma unroll
                          for (int k = 0; k < 16; ++k) { const int i = bt * 16 + k; if (i < 62) { const int p = p0 + i, pc = p < 0 ? 0 : p; const char* zp = (const char*)Z + ((size_t)b * S + pc) * (ZW * 2);
                              pa[k >> 2][k & 3] = *(const unsigned*)(zp + (unsigned)(4 * cp)); pg[k >> 2][k & 3] = *(const unsigned*)(zp + 1024 + (unsigned)(4 * cp)); } }
                          asm volatile("" : "+v"(pa[0]), "+v"(pa[1]), "+v"(pa[2]), "+v"(pa[3]), "+v"(pg[0]), "+v"(pg[1]), "+v"(pg[2]), "+v"(pg[3]));
#pragma unroll
                          for (int k = 0; k < 16; ++k) { const int i = bt * 16 + k; if (i < 62) { const int p = p0 + i; const unsigned av = pa[k >> 2][k & 3], gv = pg[k >> 2][k & 3]; f32x2 hv;
                              hv[0] = bflo(av) * g8::fast_sigmoid(bflo(gv)); hv[1] = bfhi(av) * g8::fast_sigmoid(bfhi(gv)); if (p < 0) hv = (f32x2){0.f, 0.f};
#pragma unroll
                              for (int t = (i - 30 > 0 ? i - 30 : 0); t <= (i < 31 ? i : 31); ++t) acc[t] += wv[i - t] * hv; } } }
#pragma unroll
                      for (int t = 0; t < 32; ++t) *(LAS f32x2*)(cv + (32 * ph + t) * 512 + 2 * cp) = acc[t]; }
                    __syncthreads();
                    const float4 g0 = *(const float4*)(conv_ln_g + lane * 8), g1 = *(const float4*)(conv_ln_g + lane * 8 + 4), b0 = *(const float4*)(conv_ln_b + lane * 8), b1 = *(const float4*)(conv_ln_b + lane * 8 + 4);
                    const float4 o0 = *(const float4*)(out_g + lane * 8), o1 = *(const float4*)(out_g + lane * 8 + 4);
                    const float gg[8] = {g0.x, g0.y, g0.z, g0.w, g1.x, g1.y, g1.z, g1.w}, bb[8] = {b0.x, b0.y, b0.z, b0.w, b1.x, b1.y, b1.z, b1.w};
#pragma unroll 1
                    for (int i = 0; i < 8; ++i) { const int t = wave * 8 + i; const f32x4 x0 = *(const LAS f32x4*)(cv + t * 512 + lane * 8), x1 = *(const LAS f32x4*)(cv + t * 512 + lane * 8 + 4);
                        float x[8] = {x0[0], x0[1], x0[2], x0[3], x1[0], x1[1], x1[2], x1[3]}; float sum = 0.f;
#pragma unroll
                        for (int j = 0; j < 8; ++j) sum += x[j];
                        const float mean = wave_sum(sum) * (1.f / 512.f); float q = 0.f;
#pragma unroll
                        for (int j = 0; j < 8; ++j) { const float dd = x[j] - mean; q += dd * dd; }
                        const float rstd = rsqrtf(wave_sum(q) * (1.f / 512.f) + LN_EPS); float ss = 0.f;
#pragma unroll
                        for (int j = 0; j < 8; ++j) { const float yv = (x[j] - mean) * rstd * gg[j] + bb[j]; x[j] = yv * g8::fast_sigmoid(yv); ss += x[j] * x[j]; }
                        const float rr = rsqrtf(wave_sum(ss) * (1.f / 512.f) + LN_EPS);
                        uint4 o; o.x = pk2(x[0] * rr * o0.x, x[1] * rr * o0.y); o.y = pk2(x[2] * rr * o0.z, x[3] * rr * o0.w); o.z = pk2(x[4] * rr * o1.x, x[5] * rr * o1.y); o.w = pk2(x[6] * rr * o1.z, x[7] * rr * o1.w);
                        *(uint4*)(Y + ((size_t)b * S + s0 + t) * D + YC_CONV + lane * 8) = o; }
                }
            }
            SEAM(pb + 2);
        }

        if (IN(pb + 4)) {
            PHASE_IDS
            { g8::DenseSched S{(const char*)Y, (const char*)WO_T, nullptr, T / 256, D / 256, D, nwg, wg}; g8::EpiU1 E{XB, U1, (const float*)(ws + WS_SSQ)};
              g8::gemm_phase(tid, lds, D, S, E); }
            { int tid2 = tid; asm volatile("" : "+v"(tid2));
              g8::DenseSched S{(const char*)(PB + (size_t)l * T * DPLE), (const char*)WPE_T, nullptr, T / 256, D / 256, DPLE, nwg, wg}; g8::EpiBf E{PE, D};
              g8::gemm_phase(tid2, lds, DPLE, S, E); }
            SEAM(pb + 4);
        }

        if (IN(pb + 5)) {
            PHASE_IDS
            constexpr int XRS = 4112;
            LAS unsigned char* xt = lds;
            LAS float* part = (LAS float*)lds;
            LAS int* a_e = (LAS int*)(lds + 32 * XRS);
            LAS int* a_lp = a_e + 1024; LAS float* a_g = (LAS float*)(a_lp + 1024);
            LAS int* lcnt = (LAS int*)(a_g + 1024); LAS int* lbase = lcnt + 64;
            static_assert(32 * XRS + 3 * 4096 + 512 <= MISC_OFF, "P5 LDS map");
            const bf16_t* WRT = WR + WO_WR;
            const int fr = lane & 15, fq = lane >> 4;
            if (tid < 64) lcnt[tid] = 0;
            uint2 raw[4][8];
#define P5_LOAD(tile_) do { _Pragma("unroll") for (int rr = 0; rr < 4; ++rr) { const bf16_t* rp_ = (const bf16_t*)U1 + ((size_t)(tile_) * 32 + wave * 4 + rr) * D + lane * 4; \
        _Pragma("unroll") for (int j = 0; j < 8; ++j) raw[rr][j] = *(const uint2*)(rp_ + j * 256); } } while (0)
            int ti = 0;
            for (int tile = wg; tile < T / 32 && ti < 4; tile += nwg, ++ti) {
                const int t0 = tile * 32;
                P5_LOAD(tile);
                __syncthreads();
                float mean[4], rstd[4];
#pragma unroll
                for (int rr = 0; rr < 4; ++rr) { float sum = 0.f;
#pragma unroll
                    for (int j = 0; j < 8; ++j) sum += (bflo(raw[rr][j].x) + bfhi(raw[rr][j].x)) + (bflo(raw[rr][j].y) + bfhi(raw[rr][j].y));
                    mean[rr] = wave_sum(sum) * (1.f / D); }
#define P5_OPAQUE() do { _Pragma("unroll") for (int rr = 0; rr < 4; ++rr) { _Pragma("unroll") for (int j = 0; j < 8; ++j) asm volatile("" : "+v"(raw[rr][j].x), "+v"(raw[rr][j].y)); } } while (0)
                P5_OPAQUE();
#pragma unroll
                for (int rr = 0; rr < 4; ++rr) { float q = 0.f; const float m = mean[rr];
#pragma unroll
                    for (int j = 0; j < 8; ++j) { const float a0_ = bflo(raw[rr][j].x) - m, a1_ = bfhi(raw[rr][j].x) - m, a2_ = bflo(raw[rr][j].y) - m, a3_ = bfhi(raw[rr][j].y) - m; q += (a0_ * a0_ + a1_ * a1_) + (a2_ * a2_ + a3_ * a3_); }
                    rstd[rr] = rsqrtf(wave_sum(q) * (1.f / D) + LN_EPS); }
                P5_OPAQUE();
#pragma unroll
                for (int j = 0; j < 8; ++j) { const int c = (j * 64 + lane) * 4; const float4 g = *(const float4*)(ln1_g + c), bb = *(const float4*)(ln1_b + c);
#pragma unroll
                    for (int rr = 0; rr < 4; ++rr) { const int lr = wave * 4 + rr; const size_t row = (size_t)t0 + lr; const float m = mean[rr], rs = rstd[rr];
                        uint2 o; o.x = pk2((bflo(raw[rr][j].x) - m) * rs * g.x + bb.x, (bfhi(raw[rr][j].x) - m) * rs * g.y + bb.y); o.y = pk2((bflo(raw[rr][j].y) - m) * rs * g.z + bb.z, (bfhi(raw[rr][j].y) - m) * rs * g.w + bb.w);
                        *(uint2*)(XB + row * D + c) = o; *(LAS g8::u32x2*)(xt + lr * XRS + c * 2) = (g8::u32x2){o.x, o.y};
                        if (USE_FP8) *(unsigned*)((unsigned char*)Z + row * D + c) = pk4_fp8(bflo(o.x), bfhi(o.x), bflo(o.y), bfhi(o.y)); }
                    if (j & 1) asm volatile("" ::: "memory"); }
                __syncthreads();
                f32x4 acc[2][4];
#pragma unroll
                for (int mb = 0; mb < 2; ++mb)
#pragma unroll
                    for (int n = 0; n < 4; ++n) acc[mb][n] = (f32x4){0.f, 0.f, 0.f, 0.f};
#pragma unroll 1
                for (int k2 = 0; k2 < 4; ++k2) {
                    g8::bf16x8 bh[2][4], bl[2][4];
#pragma unroll
                    for (int s2 = 0; s2 < 2; ++s2)
#pragma unroll
                        for (int n = 0; n < 4; ++n) { const int kof = (wave * 8 + k2 * 2 + s2) * 32 + fq * 8; bh[s2][n] = *(const g8::bf16x8*)(WRT + (size_t)(16 * n + fr) * D + kof); bl[s2][n] = *(const g8::bf16x8*)(WRT + (size_t)(NE + 16 * n + fr) * D + kof); }
                    asm volatile("" : "+v"(bh[0][0]), "+v"(bh[0][1]), "+v"(bh[0][2]), "+v"(bh[0][3]), "+v"(bl[0][0]), "+v"(bl[0][1]), "+v"(bl[0][2]), "+v"(bl[0][3]),
                                      "+v"(bh[1][0]), "+v"(bh[1][1]), "+v"(bh[1][2]), "+v"(bh[1][3]), "+v"(bl[1][0]), "+v"(bl[1][1]), "+v"(bl[1][2]), "+v"(bl[1][3]));
#pragma unroll
                    for (int s2 = 0; s2 < 2; ++s2) { const int kof = (wave * 8 + k2 * 2 + s2) * 32 + fq * 8;
                        const g8::bf16x8 a0 = *(const LAS g8::bf16x8*)(xt + fr * XRS + kof * 2), a1 = *(const LAS g8::bf16x8*)(xt + (16 + fr) * XRS + kof * 2);
#pragma unroll
                        for (int n = 0; n < 4; ++n) {
                            acc[0][n] = __builtin_amdgcn_mfma_f32_16x16x32_bf16(bh[s2][n], a0, acc[0][n], 0, 0, 0); acc[0][n] = __builtin_amdgcn_mfma_f32_16x16x32_bf16(bl[s2][n], a0, acc[0][n], 0, 0, 0);
                            acc[1][n] = __builtin_amdgcn_mfma_f32_16x16x32_bf16(bh[s2][n], a1, acc[1][n], 0, 0, 0); acc[1][n] = __builtin_amdgcn_mfma_f32_16x16x32_bf16(bl[s2][n], a1, acc[1][n], 0, 0, 0); } } }
                __syncthreads();
#pragma unroll
                for (int mb = 0; mb < 2; ++mb)
#pragma unroll
                    for (int n = 0; n < 4; ++n) *(LAS f32x4*)(part + ((wave * 2 + mb) * 4 + n) * 256 + lane * 4) = acc[mb][n];
                __syncthreads();
                const float rbias = r_bias[lane];
                float score[4], msel[4]; int ek[4];
#pragma unroll
                for (int r = 0; r < 4; ++r) {
                    const int tt = wave * 4 + r, mb = tt >> 4, frt = tt & 15; const int pofs = (mb * 4 + (lane >> 4)) * 256 + (((lane >> 2) & 3) * 16 + frt) * 4 + (lane & 3);
                    float logit = 0.f;
#pragma unroll
                    for (int w2 = 0; w2 < 8; ++w2) logit += part[w2 * 2048 + pofs];
                    score[r] = sigmoidf_(logit); const float sel = score[r] + rbias; const int g = lane >> 3;
                    int rk = 0;
#define RK_STEP(J) { const float o = shx<J>(sel, lane); const int ol = lane ^ J; rk += (o > sel || (o == sel && ol < lane)) ? 1 : 0; }
                    RK_STEP(1) RK_STEP(2) RK_STEP(3) RK_STEP(4) RK_STEP(5) RK_STEP(6) RK_STEP(7)
#undef RK_STEP
                    float gs = rk < 2 ? sel : 0.f; gs += swz_xor<1>(gs); gs += swz_xor<2>(gs); gs += swz_xor<4>(gs);
                    int grk = 0;
#define GK_STEP(J) { const float o = shx<8 * J>(gs, lane); const int og = g ^ J; grk += (o > gs || (o == gs && og < g)) ? 1 : 0; }
                    GK_STEP(1) GK_STEP(2) GK_STEP(3) GK_STEP(4) GK_STEP(5) GK_STEP(6) GK_STEP(7)
#undef GK_STEP
                    msel[r] = grk < 4 ? sel : -__builtin_inff(); ek[r] = 64;
                }
#pragma unroll 1
                for (int it = 0; it < TOPK; ++it) {
#pragma unroll
                    for (int r = 0; r < 4; ++r) { const float m = wave_max(msel[r]); const unsigned long long bal = __builtin_amdgcn_ballot_w64(msel[r] == m);
                        const int first = (int)__builtin_ctzll(bal); if (lane == first) { ek[r] = it; msel[r] = -__builtin_inff(); } } }
#pragma unroll
                for (int r = 0; r < 4; ++r) { const int tt = wave * 4 + r; const bool ch = ek[r] < TOPK;
                    const float gsum = wave_sum(ch ? score[r] : 0.f);
                    if (ch) { const int lp = atomicAdd((int*)(lcnt + lane), 1); const int idx = (ti * 32 + tt) * 8 + ek[r]; a_e[idx] = lane; a_lp[idx] = lp; a_g[idx] = score[r] / gsum * ROUTE_SCALE; } }
            }
#undef P5_LOAD
#undef P5_OPAQUE
            __syncthreads();
            if (tid < 64) { const int c = lcnt[tid]; int bs = 0; if (c > 0) bs = (int)atomicAdd(cntg + tid * 64, (unsigned)c); lbase[tid] = bs; }
            __syncthreads();
            for (int idx = tid; idx < ti * 256; idx += 512) { const int e = a_e[idx], pos = lbase[e] + a_lp[idx]; const int tok = (wg + (idx >> 8) * nwg) * 32 + ((idx >> 3) & 31);
                TOKL[e * T + pos] = tok; ASG[tok * 8 + (idx & 7)] = (e << 16) | pos; GATE[tok * 8 + (idx & 7)] = a_g[idx]; }
            SEAM(pb + 5);
        }

        if (IN(pb + 6)) {
            PHASE_IDS
            int vt, vr, vcn, ntr;
            { const int c = (int)cntg[lane * 64], tl_ = (c + 255) >> 8; int it = tl_, ir = c;
#pragma unroll
              for (int o = 1; o < 64; o <<= 1) { const int n1 = lane_up_i(it, lane, o), n2 = lane_up_i(ir, lane, o); if (lane >= o) { it += n1; ir += n2; } }
              vt = it - tl_; vr = ir - c; vcn = c; ntr = __builtin_amdgcn_readlane(it, 63); }
#if USE_FP8
            g8::MoeSched S{vt, vr, vcn, ntr, 4, (const char*)Z, (const char*)WR, (unsigned)(WO_W13 * 2), (unsigned)(1024u * D), TOKL, T / 256, D / 256, (unsigned)(WO_WPG * 2), D / 2, nwg, wg};
            g8::EpiUp E{HB, XB, PE, b_pg, (bf16_t*)(ws + WS_BASE), W8_INV, true};
            g8::gemm_phase<g8::EpiUp, g8::MoeSched, true>(tid, lds, D / 2, S, E);
#else
            g8::MoeSched S{vt, vr, vcn, ntr, 4, (const char*)XB, (const char*)WR, (unsigned)(WO_W13 * 2), (unsigned)(1024u * D * 2u), TOKL, T / 256, D / 256, (unsigned)(WO_WPG * 2), D, nwg, wg};
            g8::EpiUp E{HB, XB, PE, b_pg, (bf16_t*)(ws + WS_BASE), 1.f, false};
            g8::gemm_phase(tid, lds, D, S, E);
#endif
            SEAM(pb + 6);
        }

        if (IN(pb + 7)) {
            PHASE_IDS
            int vt, vr, vcn, ntr;
            { const int c = (int)cntg[lane * 64], tl_ = (c + 255) >> 8; int it = tl_, ir = c;
#pragma unroll
              for (int o = 1; o < 64; o <<= 1) { const int n1 = lane_up_i(it, lane, o), n2 = lane_up_i(ir, lane, o); if (lane >= o) { it += n1; ir += n2; } }
              vt = it - tl_; vr = ir - c; vcn = c; ntr = __builtin_amdgcn_readlane(it, 63); }
#if USE_FP8
            g8::MoeSched S{vt, vr, vcn, ntr, 8, (const char*)HB, (const char*)WR, (unsigned)(WO_W2 * 2), (unsigned)(D * DE), nullptr, 0, 0, 0u, DE / 2, nwg, wg};
            g8::EpiDown E{(unsigned char*)Y2, (unsigned char*)XB, W8_INV};
            g8::gemm_phase<g8::EpiDown, g8::MoeSched, true>(tid, lds, DE / 2, S, E);
#else
            g8::MoeSched S{vt, vr, vcn, ntr, 8, (const char*)HB, (const char*)WR, (unsigned)(WO_W2 * 2), (unsigned)(D * DE * 2), nullptr, 0, 0, 0u, DE, nwg, wg};
            g8::EpiDown E{(unsigned char*)Y2, (unsigned char*)XB, 1.f};
            g8::gemm_phase(tid, lds, DE, S, E);
#endif
            SEAM(pb + 7);
        }

        if (IN(pb + 8)) {
            PHASE_IDS
            LAS int* rsl = (LAS int*)(lds + 131072);
            __syncthreads();
            if (tid == 0) { int rs = 0; for (int e = 0; e < NE; ++e) { rsl[e] = rs; rs += (int)cntg[e * 64]; } }
            __syncthreads();
            const bool last = (l == DEPTH - 1);
            for (int row = wg * 8 + wave; row < T; row += nwg * 8) {
                float4 v[8];
#pragma unroll
                for (int j = 0; j < 8; ++j) { const uint2 bv = *(const uint2*)((const bf16_t*)(ws + WS_BASE) + (size_t)row * D + (j * 64 + lane) * 4); v[j] = make_float4(bflo(bv.x), bfhi(bv.x), bflo(bv.y), bfhi(bv.y)); const int sv = *(const int*)((const unsigned char*)XB + (size_t)row * (2 * D) + (j * 64 + lane) * 4);
                    v[j].x = fmaf(Y2_INV, __builtin_amdgcn_cvt_f32_fp8(sv, 0), v[j].x); v[j].y = fmaf(Y2_INV, __builtin_amdgcn_cvt_f32_fp8(sv, 1), v[j].y); v[j].z = fmaf(Y2_INV, __builtin_amdgcn_cvt_f32_fp8(sv, 2), v[j].z); v[j].w = fmaf(Y2_INV, __builtin_amdgcn_cvt_f32_fp8(sv, 3), v[j].w); }
#pragma unroll 4
                for (int k = 0; k < TOPK; ++k) { const int as = ASG[row * 8 + k]; const float g = GATE[row * 8 + k] * Y2_INV; const size_t slot = (size_t)rsl[as >> 16] + (as & 0xffff);
                    const unsigned char* yp = (const unsigned char*)Y2 + slot * D;
#pragma unroll
                    for (int j = 0; j < 8; ++j) { const int yv = *(const int*)(yp + (j * 64 + lane) * 4);
                        v[j].x = fmaf(g, __builtin_amdgcn_cvt_f32_fp8(yv, 0), v[j].x); v[j].y = fmaf(g, __builtin_amdgcn_cvt_f32_fp8(yv, 1), v[j].y);
                        v[j].z = fmaf(g, __builtin_amdgcn_cvt_f32_fp8(yv, 2), v[j].z); v[j].w = fmaf(g, __builtin_amdgcn_cvt_f32_fp8(yv, 3), v[j].w); } }
                float sum = 0.f;
#pragma unroll
                for (int j = 0; j < 8; ++j) sum += (v[j].x + v[j].y) + (v[j].z + v[j].w);
                const float mean = wave_sum(sum) * (1.f / D); float q = 0.f;
#pragma unroll
                for (int j = 0; j < 8; ++j) { v[j].x -= mean; v[j].y -= mean; v[j].z -= mean; v[j].w -= mean; q += (v[j].x * v[j].x + v[j].y * v[j].y) + (v[j].z * v[j].z + v[j].w * v[j].w); }
                const float rstd = rsqrtf(wave_sum(q) * (1.f / D) + LN_EPS);
#pragma unroll
                for (int j = 0; j < 8; ++j) { const int c = (j * 64 + lane) * 4; const float4 g = *(const float4*)(ln2_g + c), bb = *(const float4*)(ln2_b + c);
                    float4 y; y.x = v[j].x * rstd * g.x + bb.x; y.y = v[j].y * rstd * g.y + bb.y; y.z = v[j].z * rstd * g.z + bb.z; y.w = v[j].w * rstd * g.w + bb.w;
                    if (last) *(float4*)(ap_->out + (size_t)row * D + c) = y;
                    else { uint2 o; o.x = pk2(y.x, y.y); o.y = pk2(y.z, y.w); *(uint2*)(XB + (size_t)row * D + c) = o; *(unsigned*)(ws + WS_XB8 + (size_t)row * D + c) = pk4_fp8(bflo(o.x), bfhi(o.x), bflo(o.y), bfhi(o.y)); } }
            }
            SEAM(pb + 8);
        }
    }
#undef IN
#undef SEAM
#undef w_in
#undef b_f
#undef conv_w
#undef conv_b
#undef conv_ln_g
#undef conv_ln_b
#undef gm_ln_g
#undef gm_ln_b
#undef w_sp
#undef b_sp
#undef out_g
#undef w_o
#undef ln1_g
#undef ln1_b
#undef w_r
#undef r_bias
#undef w_e1
#undef w_e3
#undef w_e2
#undef w_sh1
#undef w_sh3
#undef w_sh2
#undef w_pe
#undef w_pg
#undef b_pg
#undef ln2_g
#undef ln2_b
#undef pin
}
}

#ifndef MK_ONE_LAUNCH
#define MK_ONE_LAUNCH 1
#endif
#ifndef PROBE_REP_MASK
#define PROBE_REP_MASK 0
#endif

extern "C" void kernel_launch(void* const* d_in, const int* in_sizes, int n_in, void* d_out, int out_size, void* d_ws, size_t ws_size, hipStream_t stream) {
    static int grid = 0;
    if (grid == 0) {
        if (n_in != 29 || in_sizes[0] != T * D || out_size != T * D || ws_size < WS_END) {
            fprintf(stderr, "kernel_launch: unexpected shapes (n_in %d, in0 %d, out %d, ws %zu; need ws >= %zu)\n", n_in, n_in > 0 ? in_sizes[0] : -1, out_size, ws_size, (size_t)WS_END); grid = -1; return; }
        int dev = 0, cus = 0, per_cu = 0;
        if (hipGetDevice(&dev) != hipSuccess || hipDeviceGetAttribute(&cus, hipDeviceAttributeMultiprocessorCount, dev) != hipSuccess) { grid = -1; return; }
        if (hipFuncSetAttribute((const void*)fwd_kernel, hipFuncAttributeMaxDynamicSharedMemorySize, LDS_BYTES) != hipSuccess) { fprintf(stderr, "kernel_launch: hipFuncSetAttribute failed\n"); grid = -1; return; }
        if (hipOccupancyMaxActiveBlocksPerMultiprocessor(&per_cu, (const void*)fwd_kernel, 512, LDS_BYTES) != hipSuccess || per_cu < 1) { fprintf(stderr, "kernel_launch: occupancy query says %d\n", per_cu); }
        (void)hipGetLastError();
        grid = cus;
    }
    if (grid < 0) return;
    (void)hipMemsetAsync((char*)d_ws + WS_CTL, 0, CTL_BYTES, stream);
    Args a{};
    for (int i = 0; i < 29; ++i) a.in[i] = (const float*)d_in[i];
    a.out = (float*)d_out; a.ws = (unsigned char*)d_ws;
#if PROBE_REP_MASK
    { int lo = 0; for (int ph = 0; ph < NPH; ++ph) { const int k = ph == 0 ? -1 : (ph - 1) % PPL; if (k >= 0 && ((PROBE_REP_MASK >> k) & 1)) {
          a.ph_lo = lo; a.ph_hi = ph + 1; hipLaunchKernelGGL(fwd_kernel, dim3(grid), dim3(512), LDS_BYTES, stream, a); lo = ph; ++a.li; } }
      a.ph_lo = lo; a.ph_hi = NPH; hipLaunchKernelGGL(fwd_kernel, dim3(grid), dim3(512), LDS_BYTES, stream, a); }
#elif MK_ONE_LAUNCH
    a.ph_lo = 0; a.ph_hi = NPH;
    hipLaunchKernelGGL(fwd_kernel, dim3(grid), dim3(512), LDS_BYTES, stream, a);
#else
    for (int ph = 0; ph < NPH; ++ph) { a.ph_lo = ph; a.ph_hi = ph + 1; hipLaunchKernelGGL(fwd_kernel, dim3(grid), dim3(512), LDS_BYTES, stream, a); }
#endif
}
```
